# Optimizing an MI355X kernel written in HIP

```python
import math
import jax, jax.numpy as jnp
from jax import lax
import numpy as np

D_MODEL = 1024
BATCH = 8
SEQ = 8192
DEPTH = 2

N_MIXERS = 2
N_FOURIER_GROUPS = 8
FOURIER_GROUP = D_MODEL // N_FOURIER_GROUPS
N_DIFF_HEADS = 8
DIFF_HEAD_DIM = D_MODEL // (2 * N_DIFF_HEADS)
DIFF_V_DIM = 2 * DIFF_HEAD_DIM
D_FF = -(-8 * D_MODEL // (3 * 256)) * 256
Q_BLOCK = 128
RMS_EPS = 1e-6
N_FOURIER_LAYERS = (DEPTH + 1) // 2
N_DIFF_LAYERS = DEPTH // 2

kernel_name = "hybrid_fnet_diffattn_alibi_encoder"


def rms_norm(x, g):
    xf = x.astype(jnp.float32)
    y = xf * lax.rsqrt(jnp.mean(xf * xf, axis=-1, keepdims=True) + RMS_EPS)
    return (y * g.astype(jnp.float32)).astype(x.dtype)


def alibi_slopes(n_heads):
    return jnp.asarray([2.0 ** (-8.0 * (h + 1) / n_heads) for h in range(n_heads)], dtype=jnp.float32)


def lambda_init_fn(layer_idx):
    return 0.8 - 0.6 * math.exp(-0.3 * layer_idx)


def fourier_mixer(xn, w_o):
    b, s, d = xn.shape
    xg = xn.reshape(b, s, N_FOURIER_GROUPS, FOURIER_GROUP).astype(jnp.float32)
    y = jnp.fft.fftn(xg, axes=(1, 3), norm="ortho").real
    y = y.reshape(b, s, d).astype(xn.dtype)
    return y @ w_o


def diff_attention_mixer(xn, w_qkv, lq1, lk1, lq2, lk2, subln_g, w_o, layer_idx):
    b, s, d = xn.shape
    h, dh, dv = N_DIFF_HEADS, DIFF_HEAD_DIM, DIFF_V_DIM
    qkv = xn @ w_qkv
    q = qkv[..., :d].reshape(b, s, h, 2, dh)
    k = qkv[..., d:2 * d].reshape(b, s, h, 2, dh)
    v = qkv[..., 2 * d:].reshape(b, s, h, dv)

    lam_init = lambda_init_fn(layer_idx)
    lam = (jnp.exp(jnp.sum(lq1.astype(jnp.float32) * lk1.astype(jnp.float32)))
           - jnp.exp(jnp.sum(lq2.astype(jnp.float32) * lk2.astype(jnp.float32)))
           + lam_init)

    scale = dh ** -0.5
    n_blk = s // Q_BLOCK
    qb = q.reshape(b, n_blk, Q_BLOCK, h, 2, dh).transpose(1, 0, 3, 4, 2, 5)
    kt = k.transpose(0, 2, 3, 1, 4)
    vt = v.transpose(0, 2, 1, 3)
    slopes = alibi_slopes(h)
    key_pos = jnp.arange(s, dtype=jnp.int32)
    starts = jnp.arange(n_blk, dtype=jnp.int32) * Q_BLOCK

    def block(args):
        q_blk, t0 = args
        scores = jnp.einsum('bhcqd,bhcsd->bhcqs', q_blk, kt).astype(jnp.float32) * scale
        q_pos = t0 + jnp.arange(Q_BLOCK, dtype=jnp.int32)
        dist = jnp.abs(q_pos[:, None] - key_pos[None, :]).astype(jnp.float32)
        bias = -slopes[:, None, None] * dist[None]
        p = jax.nn.softmax(scores + bias[None, :, None], axis=-1)
        a = p[:, :, 0] - lam * p[:, :, 1]
        return jnp.einsum('bhqs,bhse->bhqe', a.astype(vt.dtype), vt)

    o = lax.map(block, (qb, starts))
    o = o.transpose(1, 0, 3, 2, 4).reshape(b, s, h, dv)
    o = rms_norm(o, subln_g) * (1.0 - lam_init)
    return o.reshape(b, s, h * dv) @ w_o


def swiglu_ffn(xn, w_gate, w_up, w_down):
    return (jax.nn.silu(xn @ w_gate) * (xn @ w_up)) @ w_down


def setup_inputs(seed: int = 0) -> dict:
    key = jax.random.key(seed)
    ks = jax.random.split(key, 20)
    D, F = D_MODEL, D_FF

    def gain(k, shape):
        return 1.0 + 0.02 * jax.random.normal(k, shape, jnp.float32)

    def w(k, shape, fan_in):
        return jax.random.normal(k, shape, jnp.float32) * fan_in ** -0.5

    return {
        "x": jax.random.normal(ks[0], (BATCH, SEQ, D), jnp.float32),
        "norm_mix_pre": gain(ks[1], (DEPTH, D)),
        "norm_mix_post": gain(ks[2], (DEPTH, D)),
        "norm_ffn_pre": gain(ks[3], (DEPTH, D)),
        "norm_ffn_post": gain(ks[4], (DEPTH, D)),
        "fourier_w_o": w(ks[5], (N_FOURIER_LAYERS, D, D), D),
        "diff_w_qkv": w(ks[6], (N_DIFF_LAYERS, D, 3 * D), D),
        "diff_lambda_q1": 0.1 * jax.random.normal(ks[7], (N_DIFF_LAYERS, DIFF_HEAD_DIM), jnp.float32),
        "diff_lambda_k1": 0.1 * jax.random.normal(ks[8], (N_DIFF_LAYERS, DIFF_HEAD_DIM), jnp.float32),
        "diff_lambda_q2": 0.1 * jax.random.normal(ks[9], (N_DIFF_LAYERS, DIFF_HEAD_DIM), jnp.float32),
        "diff_lambda_k2": 0.1 * jax.random.normal(ks[10], (N_DIFF_LAYERS, DIFF_HEAD_DIM), jnp.float32),
        "diff_subln_g": gain(ks[11], (N_DIFF_LAYERS, DIFF_V_DIM)),
        "diff_w_o": w(ks[12], (N_DIFF_LAYERS, D, D), D),
        "ffn_w_gate": w(ks[13], (DEPTH, D, F), D),
        "ffn_w_up": w(ks[14], (DEPTH, D, F), D),
        "ffn_w_down": w(ks[15], (DEPTH, F, D), F),
    }


def reference(x, norm_mix_pre, norm_mix_post, norm_ffn_pre, norm_ffn_post,
              fourier_w_o, diff_w_qkv, diff_lambda_q1, diff_lambda_k1,
              diff_lambda_q2, diff_lambda_k2, diff_subln_g, diff_w_o,
              ffn_w_gate, ffn_w_up, ffn_w_down):
    h = x
    for i in range(DEPTH):
        xn = rms_norm(h, norm_mix_pre[i])
        j = i // N_MIXERS
        if i % N_MIXERS == 0:
            m = fourier_mixer(xn, fourier_w_o[j])
        else:
            m = diff_attention_mixer(xn, diff_w_qkv[j], diff_lambda_q1[j], diff_lambda_k1[j],
                                     diff_lambda_q2[j], diff_lambda_k2[j], diff_subln_g[j],
                                     diff_w_o[j], i)
        h = h + rms_norm(m, norm_mix_post[i])
        f = swiglu_ffn(rms_norm(h, norm_ffn_pre[i]), ffn_w_gate[i], ffn_w_up[i], ffn_w_down[i])
        h = h + rms_norm(f, norm_ffn_post[i])
    return h
```

```cpp
#include <hip/hip_runtime.h>
#include <hip/hip_cooperative_groups.h>
#include <cstdio>
#include <cstdint>
namespace cg = cooperative_groups;
namespace pg8 {
#define PG8_LAS __attribute__((address_space(3)))
typedef unsigned short bf16_t;
typedef short bf16x8 __attribute__((ext_vector_type(8)));
typedef float f32x4 __attribute__((ext_vector_type(4)));
typedef unsigned u32x4 __attribute__((ext_vector_type(4)));
constexpr int BM = 256, BK = 64, HALF = 128, HTB = HALF * BK * 2  , STAGE_BYTES = 8 * HTB, NXCD = 8, WGM = 8;

__host__ __device__ __forceinline__ int lds_byte(int r, int c) { const int st = (r >> 4) * 2 + (c >> 5), rr = r & 15, cc = c & 31, ob = rr * 64 + cc * 2; return st * 1024 + (ob ^ (((ob >> 9) & 1) << 5)); }
__host__ __device__ __forceinline__ void stage_rc(int b, int& R, int& C) { const int st = b / 1024, sb = b % 1024, swz = sb ^ (((sb >> 9) & 1) << 5); R = (st >> 1) * 16 + swz / 64; C = (st & 1) * 32 + (swz % 64) / 2; }
__host__ __device__ __forceinline__ int perm32(int rho) { const int n = rho >> 4, i = rho & 15; return 8 * (i >> 2) + 4 * n + (i & 3); }

struct Unit { int pm, pn; };
struct Gemm { const bf16_t* A; const bf16_t* Bt; int M, N, K; };

struct StaticOrder {
    int nM, nN, nwg, G, c;
    __host__ __device__ void init(int M, int N, int G_, int c_) { nM = M / BM; nN = N / BM; nwg = nM * nN; G = G_; c = c_; }
    __host__ __device__ bool next(int i, Unit& u) const {
        const long L = (long)i * G + c; if (L >= nwg) return false;
        int wgid = (int)L; { const int q = nwg / NXCD, r = nwg % NXCD, xcd = wgid % NXCD, off = wgid / NXCD; wgid = (xcd < r ? xcd * (q + 1) : r * (q + 1) + (xcd - r) * q) + off; }
        const int nig = WGM * nN, gid = wgid / nig, fm = gid * WGM, gsz = (nM - fm) < WGM ? (nM - fm) : WGM;
        u.pm = fm + ((wgid % nig) % gsz); u.pn = (wgid % nig) / gsz; return true;
    }
    __device__ __forceinline__ void a_ready(const Unit&) const {}
    __device__ __forceinline__ void done(const Unit&) const {}
};

__device__ __forceinline__ unsigned cvt_pk_bf16(float lo, float hi) { unsigned r; asm volatile("v_cvt_pk_bf16_f32 %0, %1, %2" : "=v"(r) : "v"(lo), "v"(hi)); return r; }
struct EpiBf16 {
    static constexpr bool PERM = true, AFTER_DRAIN = false;
    bf16_t* O; int ldc; int split_cols; size_t split_stride; float scale0;
    const float* rowscale;
    unsigned* kmaxh;
    __device__ __forceinline__ void operator()(const f32x4 (&acc)[2][2][4][2], const Unit& u, int wr, int wc, int fr, int fq) const {
        const int row0 = u.pm * BM + wr * 64 + fr; int colt = u.pn * BM; bf16_t* base = O;
        float sc = 1.f; int t = 0; if (split_cols) { t = colt / split_cols; base += (size_t)t * split_stride; colt -= t * split_cols; if (t == 0) sc = scale0; }
        const int col0 = colt + wc * 32 + 8 * fq;
        float mx[2] = {0.f, 0.f};
#pragma unroll
        for (int ai = 0; ai < 2; ++ai)
#pragma unroll
            for (int m = 0; m < 4; ++m) { bf16_t* rowp = base + (size_t)(row0 + ai * HALF + m * 16) * ldc + col0; const float scr_ = rowscale ? sc * rowscale[row0 + ai * HALF + m * 16] : sc;
#pragma unroll
                for (int bj = 0; bj < 2; ++bj) { f32x4 v0 = acc[ai][bj][m][0] * scr_, v1 = acc[ai][bj][m][1] * scr_;
                    u32x4 w; w.x = cvt_pk_bf16(v0[0], v0[1]); w.y = cvt_pk_bf16(v0[2], v0[3]); w.z = cvt_pk_bf16(v1[0], v1[1]); w.w = cvt_pk_bf16(v1[2], v1[3]);
                    *(u32x4*)(rowp + bj * HALF) = w;
                    if (kmaxh && t == 1) { float s = 0.f;
#pragma unroll
                        for (int e = 0; e < 4; ++e) { const float lo = __builtin_bit_cast(float, w[e] << 16), hi = __builtin_bit_cast(float, w[e] & 0xffff0000u); s += lo * lo + hi * hi; }
                        s += __shfl_xor(s, 16); s += __shfl_xor(s, 32);
                        mx[bj] = __builtin_fmaxf(mx[bj], s); } } }
        if (kmaxh && t == 1) {
#pragma unroll
            for (int bj = 0; bj < 2; ++bj) { float v = mx[bj]; v = __builtin_fmaxf(v, __shfl_xor(v, 1)); v = __builtin_fmaxf(v, __shfl_xor(v, 2)); v = __builtin_fmaxf(v, __shfl_xor(v, 4)); v = __builtin_fmaxf(v, __shfl_xor(v, 8));
                if (fr == 0 && fq == 0) atomicMax(kmaxh + (((u.pm >> 5) * 16 + (colt >> 6) + 2 * bj + (wc >> 1)) * 2 + (wc & 1)), __builtin_bit_cast(unsigned, v)); } }
    }
};
struct EpiBf16Ssq {
    static constexpr bool PERM = true, AFTER_DRAIN = false;
    bf16_t* O; int ldc; float* ssq;
    __device__ __forceinline__ void operator()(const f32x4 (&acc)[2][2][4][2], const Unit& u, int wr, int wc, int fr, int fq) const {
        const int row0 = u.pm * BM + wr * 64 + fr; const int col0 = u.pn * BM + wc * 32 + 8 * fq;
#pragma unroll
        for (int ai = 0; ai < 2; ++ai)
#pragma unroll
            for (int m = 0; m < 4; ++m) { const size_t row = (size_t)(row0 + ai * HALF + m * 16); bf16_t* rowp = O + row * ldc + col0; float s = 0.f;
#pragma unroll
                for (int bj = 0; bj < 2; ++bj) { const f32x4 v0 = acc[ai][bj][m][0], v1 = acc[ai][bj][m][1];
                    s += (v0[0] * v0[0] + v0[1] * v0[1]) + (v0[2] * v0[2] + v0[3] * v0[3]) + (v1[0] * v1[0] + v1[1] * v1[1]) + (v1[2] * v1[2] + v1[3] * v1[3]);
                    u32x4 w; w.x = cvt_pk_bf16(v0[0], v0[1]); w.y = cvt_pk_bf16(v0[2], v0[3]); w.z = cvt_pk_bf16(v1[0], v1[1]); w.w = cvt_pk_bf16(v1[2], v1[3]);
                    *(u32x4*)(rowp + bj * HALF) = w; }
                s += __shfl_xor(s, 16); s += __shfl_xor(s, 32);
                if (fq == 0) ssq[row * 16 + u.pn * 4 + wc] = s; }
    }
};
__device__ __forceinline__ float silu_mul(float g, float u) { return g * __builtin_amdgcn_rcpf(1.f + __builtin_amdgcn_exp2f(-1.4426950408889634f * g)) * u; }
struct EpiSwiglu {
    static constexpr bool PERM = true, AFTER_DRAIN = false;
    bf16_t* O; int ldc; const float* rowscale;
    __device__ __forceinline__ void operator()(const f32x4 (&acc)[2][2][4][2], const Unit& u, int wr, int wc, int fr, int fq) const {
        const int row0 = u.pm * BM + wr * 64 + fr; const int col0 = u.pn * 128 + wc * 16 + 4 * fq;
        typedef unsigned u32x2 __attribute__((ext_vector_type(2)));
#pragma unroll
        for (int ai = 0; ai < 2; ++ai)
#pragma unroll
            for (int m = 0; m < 4; ++m) { bf16_t* rowp = O + (size_t)(row0 + ai * HALF + m * 16) * ldc + col0; const float rs_ = rowscale[row0 + ai * HALF + m * 16];
#pragma unroll
                for (int bj = 0; bj < 2; ++bj) { const f32x4 v0 = acc[ai][bj][m][0] * rs_, v1 = acc[ai][bj][m][1] * rs_;
                    u32x2 w; w.x = cvt_pk_bf16(silu_mul(v0[0], v0[1]), silu_mul(v0[2], v0[3])); w.y = cvt_pk_bf16(silu_mul(v1[0], v1[1]), silu_mul(v1[2], v1[3]));
                    *(u32x2*)(rowp + bj * 64) = w; } }
    }
};

struct StackedOrder {
    int G, c;
    __device__ __forceinline__ bool next(int i, Unit& u) const { const long L = (long)i * G + c; if (L >= 1056) return false; u.pm = (int)(L >> 2); u.pn = (int)(L & 3) + (u.pm >= 132 ? 4 : 0); return true; }
    __device__ __forceinline__ void a_ready(const Unit&) const {}
    __device__ __forceinline__ void done(const Unit&) const {}
};
template <class Epi, class Sched, bool ALIGN_EPI = false, bool SP2 = false>
__device__ __forceinline__ void gemm_phase(PG8_LAS unsigned char* lds, const Gemm g, const Sched& S, const Epi& E) {
    int tid_ = threadIdx.x; asm volatile("" : "+v"(tid_)); const int tid = tid_, wid = __builtin_amdgcn_readfirstlane(tid >> 6), lane = tid & 63, wr = wid >> 2, wc = wid & 3, fr = lane & 15, fq = lane >> 4;
    const int K = g.K, nt = K / BK;
    unsigned voffA[2], voffB[2];
#pragma unroll
    for (int i = 0; i < 2; ++i) { int R, C; stage_rc(tid * 16 + i * 8192, R, C); const int Rb = Epi::PERM ? ((R & ~31) + perm32(R & 31)) : R;
        voffA[i] = (unsigned)(R * K + C) * 2u; voffB[i] = (unsigned)(Rb * K + C) * 2u; }
    const size_t kstep = (size_t)(BK * 2);
    const size_t hstep = (size_t)HALF * K * 2;
    const size_t tstep = 2 * hstep;
    const unsigned ldsw = (unsigned)wid * 1024u;
    const int aoff = lds_byte(wr * 64 + fr, fq * 8), boff = lds_byte(wc * 32 + fr, fq * 8);
#define PG8_SA(b, h) (((b) * 2 + (h)) * HTB)
#define PG8_SB(b, h) ((4 + (b) * 2 + (h)) * HTB)
#define PG8_STAGE(bufoff, gbase, voff) do { _Pragma("unroll") for (int _i = 0; _i < 2; ++_i) \
        __builtin_amdgcn_global_load_lds((const unsigned*)((const char*)(gbase) + (voff)[_i]), (PG8_LAS unsigned*)(lds + (bufoff) + ldsw + _i * 8192), 16, 0, 0); } while (0)
#define PG8_LDA(dst, b, h) do { _Pragma("unroll") for (int m = 0; m < 4; ++m) _Pragma("unroll") for (int k = 0; k < 2; ++k) dst[m][k] = *(const PG8_LAS bf16x8*)(lds + PG8_SA(b, h) + aoff + m * 2048 + k * 1024); } while (0)
#define PG8_LDB(dst, b, h) do { _Pragma("unroll") for (int n = 0; n < 2; ++n) _Pragma("unroll") for (int k = 0; k < 2; ++k) dst[n][k] = *(const PG8_LAS bf16x8*)(lds + PG8_SB(b, h) + boff + n * 2048 + k * 1024); } while (0)
#define PG8_MMA(ai, bj, At, Bt) do { __builtin_amdgcn_s_setprio(1); _Pragma("unroll") for (int m = 0; m < 4; ++m) _Pragma("unroll") for (int n = 0; n < 2; ++n) _Pragma("unroll") for (int k = 0; k < 2; ++k) \
        acc[ai][bj][m][n] = __builtin_amdgcn_mfma_f32_16x16x32_bf16(Bt[n][k], At[m][k], acc[ai][bj][m][n], 0, 0, 0); __builtin_amdgcn_s_setprio(0); } while (0)
#define PG8_WAIT_V(n) asm volatile("s_waitcnt vmcnt(" #n ")" ::: "memory")
#define PG8_WAIT_L(n) asm volatile("s_waitcnt lgkmcnt(" #n ")" ::: "memory")
#define PG8_BAR __builtin_amdgcn_s_barrier()
#define PG8_SCHED __builtin_amdgcn_sched_barrier(0)
    Unit cur, nxt; int ui = 0;
    if (!S.next(0, cur)) return;
    f32x4 acc[2][2][4][2];
#pragma unroll
    for (int a = 0; a < 2; ++a)
#pragma unroll
        for (int b = 0; b < 2; ++b)
#pragma unroll
            for (int m = 0; m < 4; ++m)
#pragma unroll
                for (int n = 0; n < 2; ++n) acc[a][b][m][n] = (f32x4){0.f, 0.f, 0.f, 0.f};
    bf16x8 At[4][2], B0[2][2], B1[2][2];
    const char* cA = (const char*)g.A + (size_t)cur.pm * tstep; const char* cB = (const char*)g.Bt + (size_t)cur.pn * tstep;
    S.a_ready(cur);
    if constexpr (SP2) {
        PG8_STAGE(PG8_SB(0, 0), cB, voffB); PG8_STAGE(PG8_SB(0, 1), cB + hstep, voffB); PG8_STAGE(PG8_SA(0, 0), cA, voffA); PG8_STAGE(PG8_SA(0, 1), cA + hstep, voffA);
        if (wr == 1) PG8_BAR;
        PG8_WAIT_V(2); PG8_BAR;
        PG8_STAGE(PG8_SB(1, 0), cB + kstep, voffB); PG8_STAGE(PG8_SA(1, 0), cA + kstep, voffA); PG8_STAGE(PG8_SB(1, 1), cB + hstep + kstep, voffB);
        PG8_WAIT_V(6); PG8_BAR;
    } else {
        PG8_STAGE(PG8_SB(0, 0), cB, voffB); PG8_STAGE(PG8_SA(0, 0), cA, voffA); PG8_STAGE(PG8_SB(0, 1), cB + hstep, voffB); PG8_STAGE(PG8_SA(0, 1), cA + hstep, voffA);
        if (wr == 1) PG8_BAR;
        PG8_WAIT_V(4); PG8_BAR;
        PG8_STAGE(PG8_SB(1, 0), cB + kstep, voffB); PG8_STAGE(PG8_SA(1, 0), cA + kstep, voffA); PG8_STAGE(PG8_SB(1, 1), cB + hstep + kstep, voffB);
        PG8_WAIT_V(6); PG8_BAR;
    }
    for (;;) {
        const bool has_next = S.next(ui + 1, nxt);
        const char* nA = has_next ? (const char*)g.A + (size_t)nxt.pm * tstep : cA; const char* nB = has_next ? (const char*)g.Bt + (size_t)nxt.pn * tstep : cB;
        for (int t = 0; t < nt; t += 2) {
            const bool last = (t == nt - 2);
            const char* a1 = cA + (size_t)(t + 1) * kstep;
            const char* a2 = last ? nA : cA + (size_t)(t + 2) * kstep; const char* b2 = last ? nB : cB + (size_t)(t + 2) * kstep;
            const char* a3 = a2 + kstep; const char* b3 = b2 + kstep;
            if (last && has_next) S.a_ready(nxt);
            if constexpr (SP2) {
            PG8_LDB(B0, 0, 0); PG8_LDB(B1, 0, 1); PG8_SCHED; PG8_LDA(At, 0, 0); PG8_STAGE(PG8_SA(1, 1), a1 + hstep, voffA);
            PG8_WAIT_V(8); PG8_WAIT_L(0); PG8_BAR; PG8_MMA(0, 0, At, B0); PG8_MMA(0, 1, At, B1); PG8_BAR; PG8_SCHED;
            PG8_LDA(At, 0, 1); PG8_STAGE(PG8_SB(0, 0), b2, voffB); PG8_STAGE(PG8_SB(0, 1), b2 + hstep, voffB); PG8_STAGE(PG8_SA(0, 0), a2, voffA);
            PG8_WAIT_V(8); PG8_WAIT_L(0); PG8_BAR; PG8_MMA(1, 0, At, B0); PG8_MMA(1, 1, At, B1); PG8_BAR; PG8_SCHED;
            PG8_LDB(B0, 1, 0); PG8_LDB(B1, 1, 1); PG8_SCHED; PG8_LDA(At, 1, 0); PG8_STAGE(PG8_SA(0, 1), a2 + hstep, voffA);
            PG8_WAIT_V(8); PG8_WAIT_L(0); PG8_BAR; PG8_MMA(0, 0, At, B0); PG8_MMA(0, 1, At, B1); PG8_BAR; PG8_SCHED;
            PG8_LDA(At, 1, 1); PG8_STAGE(PG8_SB(1, 0), b3, voffB); PG8_STAGE(PG8_SB(1, 1), b3 + hstep, voffB); PG8_STAGE(PG8_SA(1, 0), a3, voffA);
            PG8_WAIT_V(8); PG8_WAIT_L(0); PG8_BAR; PG8_MMA(1, 0, At, B0); PG8_MMA(1, 1, At, B1); PG8_BAR; PG8_SCHED;
            } else {
            PG8_LDB(B0, 0, 0); PG8_SCHED; PG8_LDA(At, 0, 0); PG8_STAGE(PG8_SA(1, 1), a1 + hstep, voffA);
            PG8_WAIT_L(8); PG8_BAR; PG8_WAIT_L(0); PG8_MMA(0, 0, At, B0); PG8_BAR; PG8_SCHED;
            PG8_LDB(B1, 0, 1); PG8_STAGE(PG8_SB(0, 0), b2, voffB);
            PG8_BAR; PG8_WAIT_L(0); PG8_MMA(0, 1, At, B1); PG8_BAR;
            PG8_LDA(At, 0, 1); PG8_STAGE(PG8_SA(0, 0), a2, voffA);
            PG8_BAR; PG8_WAIT_L(0); PG8_MMA(1, 0, At, B0); PG8_BAR; PG8_SCHED;
            PG8_STAGE(PG8_SB(0, 1), b2 + hstep, voffB);
            PG8_WAIT_V(6); PG8_BAR; PG8_MMA(1, 1, At, B1); PG8_BAR;
            PG8_LDB(B0, 1, 0); PG8_SCHED; PG8_LDA(At, 1, 0); PG8_STAGE(PG8_SA(0, 1), a2 + hstep, voffA);
            PG8_WAIT_L(8); PG8_BAR; PG8_WAIT_L(0); PG8_MMA(0, 0, At, B0); PG8_BAR; PG8_SCHED;
            PG8_LDB(B1, 1, 1); PG8_STAGE(PG8_SB(1, 0), b3, voffB);
            PG8_BAR; PG8_WAIT_L(0); PG8_MMA(0, 1, At, B1); PG8_BAR;
            PG8_LDA(At, 1, 1); PG8_STAGE(PG8_SA(1, 0), a3, voffA);
            PG8_BAR; PG8_WAIT_L(0); PG8_MMA(1, 0, At, B0); PG8_BAR; PG8_SCHED;
            PG8_STAGE(PG8_SB(1, 1), b3 + hstep, voffB);
            PG8_WAIT_V(6); PG8_BAR; PG8_MMA(1, 1, At, B1); PG8_BAR;
            }
        }
        if constexpr (ALIGN_EPI) { if (wr == 0) PG8_BAR; }
        if constexpr (!Epi::AFTER_DRAIN) { E(acc, cur, wr, wc, fr, fq); S.done(cur); }
        if (!has_next) break;
#pragma unroll
        for (int a = 0; a < 2; ++a)
#pragma unroll
            for (int b = 0; b < 2; ++b)
#pragma unroll
                for (int m = 0; m < 4; ++m)
#pragma unroll
                    for (int n = 0; n < 2; ++n) acc[a][b][m][n] = (f32x4){0.f, 0.f, 0.f, 0.f};
        cur = nxt; cA = nA; cB = nB; ++ui;
        if constexpr (ALIGN_EPI) { if (wr == 1) PG8_BAR; }
    }
    PG8_WAIT_V(0);
    if constexpr (!ALIGN_EPI) { if (wr == 0) PG8_BAR; }
    PG8_BAR;
    if constexpr (Epi::AFTER_DRAIN) { E.fused(acc, cur, wr, wc, fr, fq, lds, wid, lane); S.done(cur); }
#undef PG8_SA
#undef PG8_SB
#undef PG8_STAGE
#undef PG8_LDA
#undef PG8_LDB
#undef PG8_MMA
#undef PG8_WAIT_V
#undef PG8_WAIT_L
#undef PG8_BAR
#undef PG8_SCHED
}
}
using pg8::bf16_t;
#define LAS __attribute__((address_space(3)))
typedef unsigned u32x4 __attribute__((ext_vector_type(4)));
typedef unsigned u32x2 __attribute__((ext_vector_type(2)));
typedef float f32x4 __attribute__((ext_vector_type(4)));
typedef float f32x2 __attribute__((ext_vector_type(2)));
typedef float f32x16 __attribute__((ext_vector_type(16)));
typedef short bf16x8 __attribute__((ext_vector_type(8)));
typedef short s16x4 __attribute__((ext_vector_type(4)));

constexpr int NBATCH = 8, SEQ = 8192, DM = 1024, MTOK = NBATCH * SEQ, DFF = 2816;
constexpr float RMS_EPS = 1e-6f;
constexpr size_t MiB = 1u << 20;
constexpr size_t WS_WQKV = 0, WS_WDO = 6 * MiB, WS_WF = 8 * MiB, WS_WGU0 = 12 * MiB, WS_WGU1 = 23 * MiB, WS_WDN0 = 34 * MiB, WS_WDN1 = 40 * MiB,
    WS_F1 = 46 * MiB, WS_F2 = 47 * MiB, WS_TW = 48 * MiB, WS_CTL = 49 * MiB, WS_RSB = 58 * MiB, WS_SSQ = 50 * MiB, WS_XN = 64 * MiB, WS_U = 192 * MiB, WS_A = 448 * MiB, WS_MB = 704 * MiB,
    WS_HFF = 192 * MiB, WS_Q = 192 * MiB, WS_K = 320 * MiB, WS_V = 448 * MiB, WS_O = 576 * MiB, WS_HB = 832 * MiB, WS_END = 960 * MiB;
constexpr int LDS_BYTES = 143360;
constexpr int NPHASE = 16;
constexpr int MH = NBATCH * 33 * 128, NB_F2 = NBATCH * 33 * 8;

__device__ __forceinline__ unsigned f2bf(float f) { unsigned u = __builtin_bit_cast(unsigned, f); return (u + 0x7fffu + ((u >> 16) & 1u)) >> 16; }
typedef __bf16 bf16x2_t __attribute__((ext_vector_type(2)));
__device__ __forceinline__ unsigned pk2(float lo, float hi) { const f32x2 v = {lo, hi}; const bf16x2_t b = __builtin_convertvector(v, bf16x2_t); return __builtin_bit_cast(unsigned, b); }
__device__ __forceinline__ float bf_lo(unsigned w) { return __builtin_bit_cast(float, w << 16); }
__device__ __forceinline__ float bf_hi(unsigned w) { return __builtin_bit_cast(float, w & 0xffff0000u); }
__device__ __forceinline__ float dpp_f(float v, int ctrl_sel) {
    const int x = __builtin_bit_cast(int, v); int r;
    if (ctrl_sel == 0) r = __builtin_amdgcn_mov_dpp(x, 0xB1, 0xF, 0xF, true);
    else if (ctrl_sel == 1) r = __builtin_amdgcn_mov_dpp(x, 0x4E, 0xF, 0xF, true);
    else if (ctrl_sel == 2) r = __builtin_amdgcn_mov_dpp(x, 0x141, 0xF, 0xF, true);
    else r = __builtin_amdgcn_mov_dpp(x, 0x140, 0xF, 0xF, true);
    return __builtin_bit_cast(float, r);
}
__device__ __forceinline__ float row16_sum(float v) { v += dpp_f(v, 0); v += dpp_f(v, 1); v += dpp_f(v, 2); v += dpp_f(v, 3); return v; }
__device__ __forceinline__ float wave_sum(float v) { v = row16_sum(v); v += __shfl_xor(v, 16); v += __shfl_xor(v, 32); return v; }
__device__ __forceinline__ s16x4 tr16(const LAS unsigned char* p) {
    typedef short v4i16_t __attribute__((ext_vector_type(4)));
    return __builtin_bit_cast(s16x4, __builtin_amdgcn_ds_read_tr16_b64_v4i16((LAS v4i16_t*)p));
}
__device__ __forceinline__ bf16x8 cat8(s16x4 lo, s16x4 hi) { return (bf16x8){lo[0], lo[1], lo[2], lo[3], hi[0], hi[1], hi[2], hi[3]}; }
#define LDS_WAIT() asm volatile("s_waitcnt lgkmcnt(0)" ::: "memory")

struct Args { const float* in[16]; float* out; unsigned char* ws; int ph_lo, ph_hi; };
typedef const __attribute__((address_space(4))) Args CArgs;

__device__ __forceinline__ int idx_next(int idx, int step) { int t = idx + step; asm volatile("" : "+v"(t)); return t; }
__device__ __forceinline__ void p0_transpose_item(const float* W, int K, int N, bf16_t* WT, int rmul, int radd, LAS float* scr, int item, int lane, const float* gain) {
    const int nblk = N / 32, kb = item / nblk, nb = item % nblk, k0 = 64 * kb, n0 = 32 * nb;
#pragma unroll
    for (int i = 0; i < 8; ++i) { const int kk = 8 * i + (lane >> 3), ch = lane & 7;
        const f32x4 w4 = *(const f32x4*)(W + (size_t)(k0 + kk) * N + n0 + 4 * ch); const float gk = gain ? gain[k0 + kk] : 1.f;
        LAS float* d = scr + kk * 33 + 4 * ch; d[0] = w4.x * gk; d[1] = w4.y * gk; d[2] = w4.z * gk; d[3] = w4.w * gk; }
    LDS_WAIT(); asm volatile("" ::: "memory");
    const int c = lane & 7;
#pragma unroll
    for (int j = 0; j < 4; ++j) { const int n = (lane >> 3) + 8 * j; const LAS float* s = scr + (8 * c) * 33 + n;
        u32x4 o; o.x = pk2(s[0 * 33], s[1 * 33]); o.y = pk2(s[2 * 33], s[3 * 33]); o.z = pk2(s[4 * 33], s[5 * 33]); o.w = pk2(s[6 * 33], s[7 * 33]);
        *(u32x4*)(WT + (size_t)((n0 + n) * rmul + radd) * K + k0 + 8 * c) = o; }
    LDS_WAIT(); asm volatile("" ::: "memory");
}
__device__ __forceinline__ void phase_prologue(CArgs& a, LAS unsigned char* lds, int G) {
    int tid_ = threadIdx.x; asm volatile("" : "+v"(tid_)); const int lane = tid_ & 63, wave = __builtin_amdgcn_readfirstlane(tid_ >> 6), gw = blockIdx.x * 8 + wave, NGW = G * 8;
    unsigned char* ws = a.ws;
    LAS float* scr = (LAS float*)(lds + wave * 16384);
    constexpr int I_QKV = 16 * 96, I_DO = 16 * 32, I_G = 16 * 88, I_DN = 44 * 32;
    constexpr int NITEMS = I_QKV + I_DO + 4 * I_G + 2 * I_DN;
    for (int it = gw; it < NITEMS; it += NGW) {
        int r = it;
        if (r < I_QKV) { p0_transpose_item(a.in[6], DM, 3 * DM, (bf16_t*)(ws + WS_WQKV), 1, 0, scr, r, lane, a.in[1] + DM); continue; } r -= I_QKV;
        if (r < I_DO) { p0_transpose_item(a.in[12], DM, DM, (bf16_t*)(ws + WS_WDO), 1, 0, scr, r, lane, nullptr); continue; } r -= I_DO;
        if (r < 4 * I_G) { const int which = r / I_G, l = which >> 1, up = which & 1; r -= which * I_G;
            p0_transpose_item((up ? a.in[14] : a.in[13]) + (size_t)l * DM * DFF, DM, DFF, (bf16_t*)(ws + (l ? WS_WGU1 : WS_WGU0)), 2, up, scr, r, lane, a.in[3] + l * DM); continue; } r -= 4 * I_G;
        { const int l = r / I_DN; r -= l * I_DN; p0_transpose_item(a.in[15] + (size_t)l * DFF * DM, DFF, DM, (bf16_t*)(ws + (l ? WS_WDN1 : WS_WDN0)), 1, 0, scr, r, lane, nullptr); }
    }
    {
        LAS float* tabc = scr; LAS float* tabs = scr + 128;
        tabc[lane] = cospif((float)lane * (1.f / 64.f)); tabc[lane + 64] = cospif((float)(lane + 64) * (1.f / 64.f));
        tabs[lane] = sinpif((float)lane * (1.f / 64.f)); tabs[lane + 64] = sinpif((float)(lane + 64) * (1.f / 64.f));
        LDS_WAIT(); asm volatile("" ::: "memory");
        const float* wo = a.in[5]; bf16_t* wf = (bf16_t*)(ws + WS_WF);
        for (int it = gw; it < 2048; it += NGW) {
            const int g = it >> 8, nc = (it >> 4) & 15, cc = it & 15;
            float ac[8], as[8];
#pragma unroll
            for (int i = 0; i < 8; ++i) { ac[i] = 0.f; as[i] = 0.f; }
            for (int l = 0; l < 128; ++l) {
                const float w = wo[(size_t)(g * 128 + l) * DM + nc * 64 + lane];
#pragma unroll
                for (int i = 0; i < 8; ++i) { const int idx = (l * (cc * 8 + i)) & 127; ac[i] += tabc[idx] * w; as[i] += tabs[idx] * w; }
            }
            const float s = 0.08838834764831845f;
            u32x4 oc, os;
            oc.x = pk2(ac[0] * s, ac[1] * s); oc.y = pk2(ac[2] * s, ac[3] * s); oc.z = pk2(ac[4] * s, ac[5] * s); oc.w = pk2(ac[6] * s, ac[7] * s);
            os.x = pk2(as[0] * s, as[1] * s); os.y = pk2(as[2] * s, as[3] * s); os.z = pk2(as[4] * s, as[5] * s); os.w = pk2(as[6] * s, as[7] * s);
            bf16_t* dst = wf + (size_t)(nc * 64 + lane) * 1024 + g * 128 + cc * 8;
            *(u32x4*)dst = oc; *(u32x4*)(dst + (size_t)1024 * 1024) = os;
        }
    }
    {
        const int gt = gw * 64 + lane, NT = NGW * 64;
        bf16_t* F1 = (bf16_t*)(ws + WS_F1); bf16_t* F2 = (bf16_t*)(ws + WS_F2); float* TW = (float*)(ws + WS_TW);
        for (int idx = gt; idx < 128 * 64; idx = idx_next(idx, NT)) {
            const int mg = idx >> 6, n1 = idx & 63, s = mg >> 5, ri = (mg >> 4) & 1, kk = mg & 15, k1 = 16 * s + kk, ang = (k1 * n1) & 63;
            const float v = ri ? -sinpif((float)ang * (1.f / 32.f)) : cospif((float)ang * (1.f / 32.f));
            F1[idx] = (bf16_t)f2bf(v);
        }
        for (int idx = gt; idx < 256 * 256; idx = idx_next(idx, NT)) {
            const int m = idx >> 8, K = idx & 255, ri = m >> 7, k2 = m & 127, rip = K >> 7, n2 = K & 127, ang = (k2 * n2) & 127;
            const float c = cospif((float)ang * (1.f / 64.f)), s = sinpif((float)ang * (1.f / 64.f));
            const float v = (ri == rip) ? c : (ri == 0 ? s : -s);
            F2[idx] = (bf16_t)f2bf(v);
        }
        for (int idx = gt; idx < 64 * 128; idx = idx_next(idx, NT)) {
            const int k1 = idx >> 7, n2 = idx & 127, ang = k1 * n2;
            TW[2 * idx] = cospif((float)ang * (1.f / 4096.f)) * 0.125f; TW[2 * idx + 1] = sinpif((float)ang * (1.f / 4096.f)) * 0.125f;
        }
    }
}

__device__ __forceinline__ void phase_fft1(CArgs& a, LAS unsigned char* lds, int G) {
    int tid_ = threadIdx.x; asm volatile("" : "+v"(tid_)); const int tid = tid_, lane = tid & 63, wave = __builtin_amdgcn_readfirstlane(tid >> 6), r = lane & 31, h = lane >> 5, g16 = lane >> 4, q4 = (lane & 15) >> 2, p4 = lane & 3;
    const int s = wave >> 1, ch = wave & 1;
    constexpr int RS = 2048;
    const float* x = a.in[0]; const float* gpre = a.in[1];
    const bf16_t* F1 = (const bf16_t*)(a.ws + WS_F1); const float* TW = (const float*)(a.ws + WS_TW); bf16_t* U = (bf16_t*)(a.ws + WS_U);
    bf16x8 af[4];
    { const int ri_ = r >> 4, k1_ = 16 * s + (r & 15);
#pragma unroll
      for (int ks = 0; ks < 4; ++ks)
#pragma unroll
        for (int j = 0; j < 8; ++j) { const int ang = (k1_ * (16 * ks + 8 * h + j)) & 63; const float v = ri_ ? -sinpif((float)ang * (1.f / 32.f)) : cospif((float)ang * (1.f / 32.f)); af[ks][j] = (short)f2bf(v); } }
    f32x4 gv[4];
#pragma unroll
    for (int j = 0; j < 4; ++j) gv[j] = *(const f32x4*)(gpre + 256 * j + 4 * lane);
    for (int u = blockIdx.x; u < NBATCH * 128; u += G) {
        const int b = u >> 7, n2 = u & 127;
        __syncthreads();
#pragma unroll
        for (int half = 0; half < 2; ++half) {
            f32x4 v[4][4];
#pragma unroll
            for (int i = 0; i < 4; ++i) { const int n1 = 8 * wave + 4 * half + i;
#pragma unroll
                for (int j = 0; j < 4; ++j) v[i][j] = __builtin_nontemporal_load((const f32x4*)(x + ((size_t)(b * SEQ + 128 * n1 + n2)) * DM + 256 * j + 4 * lane)); }
#pragma unroll
            for (int i = 0; i < 4; ++i) { const int n1 = 8 * wave + 4 * half + i; float ss = 0.f;
#pragma unroll
                for (int j = 0; j < 4; ++j) ss += (v[i][j].x * v[i][j].x + v[i][j].y * v[i][j].y) + (v[i][j].z * v[i][j].z + v[i][j].w * v[i][j].w);
                const float rn = rsqrtf(wave_sum(ss) * (1.f / DM) + RMS_EPS);
#pragma unroll
                for (int j = 0; j < 4; ++j) { const f32x4 o = v[i][j] * rn * gv[j]; u32x2 w; w.x = pk2(o.x, o.y); w.y = pk2(o.z, o.w); *(LAS u32x2*)(lds + n1 * RS + (256 * j + 4 * lane) * 2) = w; } }
        }
        __syncthreads();
        f32x2 tw[8];
#pragma unroll
        for (int i = 0; i < 8; ++i) { const int k1 = 16 * s + (i & 3) + 8 * (i >> 2) + 4 * h, ang = k1 * n2; tw[i] = (f32x2){cospif((float)ang * (1.f / 4096.f)) * 0.125f, sinpif((float)ang * (1.f / 4096.f)) * 0.125f}; }
        if (s < 3)
#pragma unroll 2
        for (int cbk = 0; cbk < 16; ++cbk) {
            f32x16 acc = {};
#pragma unroll
            for (int ks = 0; ks < 4; ++ks) {
                const LAS unsigned char* base = lds + (16 * ks + 8 * h + q4) * RS + (ch * 512 + cbk * 32 + (g16 & 1) * 16 + 4 * p4) * 2;
                const s16x4 lo = tr16(base), hi = tr16(base + 4 * RS);
                acc = __builtin_amdgcn_mfma_f32_32x32x16_bf16(af[ks], cat8(lo, hi), acc, 0, 0, 0);
            }
            const int c = ch * 512 + cbk * 32 + r;
#pragma unroll
            for (int i = 0; i < 8; ++i) { const int k1 = 16 * s + (i & 3) + 8 * (i >> 2) + 4 * h;
                const float tre = acc[i], tim = acc[i + 8];
                const float ure = tre * tw[i].x + tim * tw[i].y, uim = tim * tw[i].x - tre * tw[i].y;
                bf16_t* dst = U + (((size_t)(b * 64 + k1) * 2) * 128 + n2) * DM + c;
                if (k1 <= 32) { dst[0] = (bf16_t)f2bf(ure); dst[(size_t)128 * DM] = (bf16_t)f2bf(uim); } }
        }
    }
}

__device__ __forceinline__ void phase_fft2(CArgs& a, LAS unsigned char* lds, int G) {
    int tid_ = threadIdx.x; asm volatile("" : "+v"(tid_)); const int tid = tid_, lane = tid & 63, wave = __builtin_amdgcn_readfirstlane(tid >> 6), r = lane & 31, h = lane >> 5, g16 = lane >> 4, q4 = (lane & 15) >> 2, p4 = lane & 3;
    constexpr int RS = 272;
    const bf16_t* U = (const bf16_t*)(a.ws + WS_U); const bf16_t* F2 = (const bf16_t*)(a.ws + WS_F2); bf16_t* A = (bf16_t*)(a.ws + WS_A);
    for (int u = blockIdx.x; u < NB_F2; u += G) {
        const int b = u / 264, k1 = (u % 264) >> 3, cb = u & 7;
        __syncthreads();
#pragma unroll
        for (int pass = 0; pass < 8; ++pass) { const int row = pass * 32 + (tid >> 4), c16 = tid & 15;
            const u32x4 v = *(const u32x4*)(U + ((size_t)(b * 64 + k1) * 256 + row) * DM + cb * 128 + c16 * 8);
            *(LAS u32x4*)(lds + row * RS + c16 * 16) = v; }
        __syncthreads();
        f32x16 acc[4];
#pragma unroll
        for (int i = 0; i < 4; ++i) acc[i] = (f32x16){};
#pragma unroll 4
        for (int ks = 0; ks < 16; ++ks) {
            const bf16x8 af = *(const bf16x8*)(F2 + (wave * 32 + r) * 256 + 16 * ks + 8 * h);
#pragma unroll
            for (int cbk = 0; cbk < 4; ++cbk) {
                const LAS unsigned char* base = lds + (16 * ks + 8 * h + q4) * RS + (cbk * 32 + (g16 & 1) * 16 + 4 * p4) * 2;
                const s16x4 lo = tr16(base), hi = tr16(base + 4 * RS);
                acc[cbk] = __builtin_amdgcn_mfma_f32_32x32x16_bf16(af, cat8(lo, hi), acc[cbk], 0, 0, 0);
            }
        }
        const int ri = wave >> 2;
#pragma unroll
        for (int cbk = 0; cbk < 4; ++cbk)
#pragma unroll
            for (int reg = 0; reg < 16; ++reg) { const int k2 = 32 * (wave & 3) + (reg & 3) + 8 * (reg >> 2) + 4 * h; const size_t arow = (size_t)ri * MH + (size_t)(b * 33 + k1) * 128 + k2;
                A[arow * 1024 + cb * 128 + cbk * 32 + r] = (bf16_t)f2bf(acc[cbk][reg] * 0.08838834764831845f); }
    }
}

constexpr int EWR = 4;
template <bool IN_BF16, bool OUT_F32>
__device__ __forceinline__ void phase_ew(const void* hin_, const bf16_t* mb, const float* ssq, const float* gpost, const float* gnext, void* hout_, bf16_t* xn, int G) {
    int tid_ = threadIdx.x; asm volatile("" : "+v"(tid_)); const int lane = tid_ & 63, wave = __builtin_amdgcn_readfirstlane(tid_ >> 6), gw = blockIdx.x * 8 + wave, NGW = G * 8;
    f32x4 gp[4];
#pragma unroll
    for (int j = 0; j < 4; ++j) gp[j] = *(const f32x4*)(gpost + 256 * j + 4 * lane);
    typedef f32x4 hraw_t;
#define EW_LOAD(HV_, MW_, SP_, m0_) do { _Pragma("unroll") for (int i = 0; i < EWR; ++i) { SP_[i] = ssq[(size_t)((m0_) + i) * 16 + (lane & 15)]; \
        _Pragma("unroll") for (int j = 0; j < 4; ++j) { const size_t off = (size_t)((m0_) + i) * DM + 256 * j + 4 * lane; \
            HV_[i][j] = __builtin_nontemporal_load((const u32x2*)((const bf16_t*)hin_ + off)); \
            MW_[i][j] = __builtin_nontemporal_load((const u32x2*)(mb + off)); } } } while (0)
#define EW_PROC(HV_, MW_, SP_, m0_) do { _Pragma("unroll") for (int i = 0; i < EWR; ++i) { \
        float t = SP_[i]; t = row16_sum(t); \
        const float rstd = rsqrtf(t * (1.f / DM) + RMS_EPS); float ss = 0.f; \
        _Pragma("unroll") for (int j = 0; j < 4; ++j) { const size_t off = (size_t)((m0_) + i) * DM + 256 * j + 4 * lane; \
            const f32x4 mf = (f32x4){bf_lo(MW_[i][j].x), bf_hi(MW_[i][j].x), bf_lo(MW_[i][j].y), bf_hi(MW_[i][j].y)}; \
            const f32x4 hf = (f32x4){bf_lo(HV_[i][j].x), bf_hi(HV_[i][j].x), bf_lo(HV_[i][j].y), bf_hi(HV_[i][j].y)}; const f32x4 v = hf + mf * rstd * gp[j]; \
            if (OUT_F32) __builtin_nontemporal_store(v, (f32x4*)((float*)hout_ + off)); \
            else { u32x2 w; w.x = pk2(v.x, v.y); w.y = pk2(v.z, v.w); *(u32x2*)((bf16_t*)hout_ + off) = w; } \
            ss += (v.x * v.x + v.y * v.y) + (v.z * v.z + v.w * v.w); } \
        if (gnext) { const float r2 = rsqrtf(wave_sum(ss) * (1.f / DM) + RMS_EPS); if (lane == 0) ((float*)xn)[(m0_) + i] = r2; } } } while (0)
    const int step = NGW * EWR;
    static_assert(IN_BF16, "the f32-input residual pass is the Fourier one");
    u32x2 hvA[EWR][4], hvB[EWR][4], mwA[EWR][4], mwB[EWR][4]; float spA[EWR], spB[EWR];
    int m0 = gw * EWR;
    if (m0 < MTOK) EW_LOAD(hvA, mwA, spA, m0);
    while (m0 < MTOK) {
        const int m1 = m0 + step;
        if (m1 < MTOK) EW_LOAD(hvB, mwB, spB, m1);
        EW_PROC(hvA, mwA, spA, m0);
        if (m1 >= MTOK) break;
        m0 = m1 + step;
        if (m0 < MTOK) EW_LOAD(hvA, mwA, spA, m0);
        EW_PROC(hvB, mwB, spB, m1);
    }
#undef EW_LOAD
#undef EW_PROC
}

__device__ __forceinline__ void phase_ew_fourier(const float* x, const bf16_t* pq, const float* gpost, const float* gnext, bf16_t* hb, bf16_t* xn, int G) {
    int tid_ = threadIdx.x; asm volatile("" : "+v"(tid_)); const int lane = tid_ & 63, wave = __builtin_amdgcn_readfirstlane(tid_ >> 6), gw = blockIdx.x * 8 + wave, NGW = G * 8;
    f32x4 gp[4], gn[4];
#pragma unroll
    for (int j = 0; j < 4; ++j) { gp[j] = *(const f32x4*)(gpost + 256 * j + 4 * lane); gn[j] = *(const f32x4*)(gnext + 256 * j + 4 * lane); }
    for (int m0 = gw * EWR; m0 < MTOK; m0 += NGW * EWR) {
        f32x4 hv[EWR][4]; u32x2 pw[EWR][4], qw[EWR][4]; float sg[EWR];
#pragma unroll
        for (int i = 0; i < EWR; ++i) { const int m = m0 + i, b = m >> 13, k = m & 8191, k1 = k & 63, k2 = k >> 6;
            const bool dir = (k1 <= 32); const size_t src = dir ? (size_t)(b * 33 + k1) * 128 + k2 : (size_t)(b * 33 + (64 - k1)) * 128 + (127 - k2);
            sg[i] = dir ? 1.f : -1.f;
#pragma unroll
            for (int j = 0; j < 4; ++j) { const int co = 256 * j + 4 * lane;
                hv[i][j] = __builtin_nontemporal_load((const f32x4*)(x + (size_t)m * DM + co));
                pw[i][j] = *(const u32x2*)(pq + src * DM + co); qw[i][j] = *(const u32x2*)(pq + ((size_t)MH + src) * DM + co); } }
#pragma unroll
        for (int i = 0; i < EWR; ++i) {
            f32x4 mv[4]; float s1 = 0.f;
#pragma unroll
            for (int j = 0; j < 4; ++j) { const f32x4 pf = (f32x4){bf_lo(pw[i][j].x), bf_hi(pw[i][j].x), bf_lo(pw[i][j].y), bf_hi(pw[i][j].y)}, qf = (f32x4){bf_lo(qw[i][j].x), bf_hi(qw[i][j].x), bf_lo(qw[i][j].y), bf_hi(qw[i][j].y)};
                mv[j] = pf + qf * sg[i]; s1 += (mv[j].x * mv[j].x + mv[j].y * mv[j].y) + (mv[j].z * mv[j].z + mv[j].w * mv[j].w); }
            const float rstd = rsqrtf(wave_sum(s1) * (1.f / DM) + RMS_EPS);
            float ss = 0.f;
#pragma unroll
            for (int j = 0; j < 4; ++j) { const size_t off = (size_t)(m0 + i) * DM + 256 * j + 4 * lane;
                const f32x4 v = hv[i][j] + mv[j] * rstd * gp[j]; hv[i][j] = v;
                u32x2 w; w.x = pk2(v.x, v.y); w.y = pk2(v.z, v.w); __builtin_nontemporal_store(w, (u32x2*)(hb + off));
                ss += (v.x * v.x + v.y * v.y) + (v.z * v.z + v.w * v.w); }
            const float r2 = rsqrtf(wave_sum(ss) * (1.f / DM) + RMS_EPS);
            if (lane == 0) ((float*)xn)[m0 + i] = r2;
        }
    }
}
__device__ __forceinline__ void phase_knorm(CArgs& a, int G) {
    int tid_ = threadIdx.x; asm volatile("" : "+v"(tid_)); const int lane = tid_ & 63, wave = __builtin_amdgcn_readfirstlane(tid_ >> 6), gw = blockIdx.x * 8 + wave, NGW = G * 8;
    const bf16_t* K = (const bf16_t*)(a.ws + WS_K); unsigned* kmax2 = (unsigned*)(a.ws + WS_CTL);
    for (int ch = gw; ch < MTOK / 32; ch += NGW) {
        float mx = 0.f;
        for (int i = 0; i < 32; ++i) {
            const bf16_t* p = K + (size_t)(ch * 32 + i) * DM + 16 * lane;
            const u32x4 v0 = *(const u32x4*)p, v1 = *(const u32x4*)(p + 8);
            float s = 0.f;
#pragma unroll
            for (int e = 0; e < 4; ++e) { const float a0 = bf_lo(v0[e]), a1 = bf_hi(v0[e]), b0 = bf_lo(v1[e]), b1 = bf_hi(v1[e]); s += (a0 * a0 + a1 * a1) + (b0 * b0 + b1 * b1); }
            s += __shfl_xor(s, 1); s += __shfl_xor(s, 2);
            mx = __builtin_fmaxf(mx, s);
        }
        if ((lane & 3) == 0) atomicMax(kmax2 + (ch >> 8) * 16 + (lane >> 2), __builtin_bit_cast(unsigned, mx));
    }
}

__device__ __forceinline__ void glds16(const void* gsrc, unsigned lds_dst) { unsigned keep;
    asm volatile("s_mov_b32 %0, m0\n\ts_mov_b32 m0, %2\n\ts_nop 0\n\tglobal_load_lds_dwordx4 %1, off\n\ts_mov_b32 m0, %0" : "=&s"(keep) : "v"(gsrc), "s"(lds_dst) : "memory"); }
__device__ __forceinline__ void phase_attn(CArgs& a, LAS unsigned char* lds, int G, int rep) {
    int tid_ = threadIdx.x; asm volatile("" : "+v"(tid_)); const int tid = tid_, lane = tid & 63, wave = __builtin_amdgcn_readfirstlane(tid >> 6), r = lane & 31, h = lane >> 5, g16 = lane >> 4, q4 = (lane & 15) >> 2, p4 = lane & 3;
    const int comp = wave >> 2, qs = wave & 3;
    const bf16_t* Q = (const bf16_t*)(a.ws + WS_Q); const bf16_t* K = (const bf16_t*)(a.ws + WS_K); const bf16_t* V = (const bf16_t*)(a.ws + WS_V); bf16_t* O = (bf16_t*)(a.ws + WS_O);
    unsigned* ctl = (unsigned*)(a.ws + WS_CTL);
    float s1 = 0.f, s2 = 0.f;
    for (int i = 0; i < 64; ++i) { s1 += a.in[7][i] * a.in[8][i]; s2 += a.in[9][i] * a.in[10][i]; }
    const float lam_init = 0.8f - 0.6f * 0.74081822068171786607f;
    const float lam = expf(s1) - expf(s2) + lam_init;
    const float* subg = a.in[11];
    constexpr int NKT = SEQ / 64, CTL_OFF = 131072, SLOT = 32768, NSLOT = 4;
    const unsigned lds0 = (unsigned)(uintptr_t)lds;
    const int krow = 8 * wave + (lane >> 3), kc = (lane & 7) ^ ((krow >> 1) & 7);
    const int vrow = 4 * wave + (lane >> 4), vc = (lane & 15) ^ ((vrow & 3) << 2);
    const int goK = krow * DM + kc * 8, goV = vrow * DM + vc * 8;
    int kofs[4], vofs[4];
#pragma unroll
    for (int i = 0; i < 4; ++i) { kofs[i] = r * 128 + (((2 * i + h) ^ ((r >> 1) & 7)) * 16); vofs[i] = (4 * h + q4) * 256 + ((i ^ q4) * 64) + (g16 & 1) * 32 + p4 * 8; }
    volatile LAS unsigned* lctl = (volatile LAS unsigned*)(lds + CTL_OFF);
    for (int qi = 0; qi < 8; ++qi) {
        const int xq = (blockIdx.x + qi) & 7;
        __syncthreads();
        if (tid == 0) lctl[0] = atomicAdd(ctl + 128 + 8 * rep + xq, 1u);
        for (;;) {
            __syncthreads();
            const int idx = (int)lctl[0];
            if (idx >= 512) break;
            unsigned nidx = 0u; if (tid == 0) nidx = atomicAdd(ctl + 128 + 8 * rep + xq, 1u);
            const int hh = 7 - (idx >> 6), b = (xq + hh) & 7, qblk = idx & 63;
            const float slope2 = exp2f(-(float)(hh + 1)) * 1.4426950408889634f;
            const int q0 = qblk * 128, qw0 = q0 + 32 * qs, qpos = qw0 + r;
            const int R = (int)(135.0f / slope2) + 1;
            int kt_lo = (q0 - 63 - R + 63) >> 6; kt_lo = kt_lo < 0 ? 0 : kt_lo;
            int kt_hi = (q0 + 127 + R) >> 6; kt_hi = kt_hi > NKT - 1 ? NKT - 1 : kt_hi;
            const bf16_t* Kt0 = K + ((size_t)b * SEQ) * DM + hh * 128 + goK;
            const bf16_t* Vt0 = V + ((size_t)b * SEQ) * DM + hh * 128 + goV;
#define AT_ISSUE(kt_, sl_) do { const size_t go_ = (size_t)(kt_) * 64 * DM; const unsigned d_ = (unsigned)__builtin_amdgcn_readfirstlane((int)(lds0 + (unsigned)((sl_) * SLOT + wave * 1024))); \
                glds16(Kt0 + go_, d_); glds16(Kt0 + go_ + 64, d_ + 8192u); glds16(Vt0 + go_, d_ + 16384u); glds16(Vt0 + go_ + (size_t)32 * DM, d_ + 24576u); } while (0)
#define AT_CLAMP(k_) ((k_) <= kt_hi ? (k_) : kt_hi)
            asm volatile("s_waitcnt vmcnt(0)" ::: "memory");
            AT_ISSUE(kt_lo, 0); AT_ISSUE(AT_CLAMP(kt_lo + 1), 1); AT_ISSUE(AT_CLAMP(kt_lo + 2), 2);
            const bf16_t* Qrow = Q + ((size_t)(b * SEQ + qpos)) * DM + hh * 128 + comp * 64;
            bf16x8 qf[4]; float qn = 0.f;
#pragma unroll
            for (int d0 = 0; d0 < 4; ++d0) { qf[d0] = *(const bf16x8*)(Qrow + 16 * d0 + 8 * h);
                const u32x4 w = __builtin_bit_cast(u32x4, qf[d0]);
#pragma unroll
                for (int e = 0; e < 4; ++e) { const float x0 = bf_lo(w[e]), x1 = bf_hi(w[e]); qn += x0 * x0 + x1 * x1; } }
            qn += __shfl_xor(qn, 32);
            const float kmx = __builtin_bit_cast(float, __hip_atomic_load(ctl + 256 + (b * 16 + hh * 2 + comp) * 2, __ATOMIC_RELAXED, __HIP_MEMORY_SCOPE_AGENT))
                            + __builtin_bit_cast(float, __hip_atomic_load(ctl + 256 + (b * 16 + hh * 2 + comp) * 2 + 1, __ATOMIC_RELAXED, __HIP_MEMORY_SCOPE_AGENT));
            const float Bi = sqrtf(qn * kmx) * 1.002f + 0.05f;
            f32x16 ot[4];
#pragma unroll
            for (int i = 0; i < 4; ++i) ot[i] = (f32x16){};
            f32x4 lacc = (f32x4){0.f, 0.f, 0.f, 0.f};
            const short one_ = ((lane & 15) == ((lane >> 4) & 1)) ? (short)0x3F80 : (short)0;
            const bf16x8 onesA = (bf16x8){one_, one_, one_, one_, one_, one_, one_, one_};
#define AT_CINIT(S_, kt_) do { \
                if ((kt_) * 64 + 63 <= qw0) { const float L_ = slope2 * (float)((kt_) * 64 + 4 * h - qpos) - Bi; \
                    _Pragma("unroll") for (int blk = 0; blk < 2; ++blk) _Pragma("unroll") for (int reg = 0; reg < 16; ++reg) S_[blk][reg] = __builtin_fmaf(slope2, (float)((reg & 3) + 8 * (reg >> 2) + 32 * blk), L_); } \
                else if ((kt_) * 64 >= qw0 + 31) { const float L_ = slope2 * (float)(qpos - (kt_) * 64 - 4 * h) - Bi; \
                    _Pragma("unroll") for (int blk = 0; blk < 2; ++blk) _Pragma("unroll") for (int reg = 0; reg < 16; ++reg) S_[blk][reg] = __builtin_fmaf(-slope2, (float)((reg & 3) + 8 * (reg >> 2) + 32 * blk), L_); } \
                else { const float dq_ = (float)(qpos - (kt_) * 64 - 4 * h); \
                    _Pragma("unroll") for (int blk = 0; blk < 2; ++blk) _Pragma("unroll") for (int reg = 0; reg < 16; ++reg) S_[blk][reg] = -slope2 * __builtin_fabsf(dq_ - (float)((reg & 3) + 8 * (reg >> 2) + 32 * blk)) - Bi; } } while (0)
            f32x16 sa[2];
            AT_CINIT(sa, kt_lo);
            asm volatile("s_waitcnt vmcnt(8)" ::: "memory"); __builtin_amdgcn_s_barrier(); asm volatile("" ::: "memory");
#define SB() __builtin_amdgcn_sched_barrier(0)
#define AT_SMQ(PW_, SRC_, b_, d_) do { ee_[2 * (d_)] = __builtin_amdgcn_exp2f(SRC_[(b_) + 2 * (d_)]); ee_[2 * (d_) + 1] = __builtin_amdgcn_exp2f(SRC_[(b_) + 2 * (d_) + 1]); \
                if ((d_) >= 1) PW_[(d_) - 1] = pk2(ee_[2 * (d_) - 2], ee_[2 * (d_) - 1]); if ((d_) == 3) PW_[3] = pk2(ee_[6], ee_[7]); } while (0)
#define AT_PV_STAGE(KS_, VLO_, VHI_, PWC_, NLO_, NHI_, FILL_) do { const bf16x8 pf_ = __builtin_bit_cast(bf16x8, PWC_); float ee_[8]; \
                lacc = __builtin_amdgcn_mfma_f32_16x16x32_bf16(onesA, pf_, lacc, 0, 0, 0); SB(); \
                _Pragma("unroll") for (int dvb = 0; dvb < 4; ++dvb) { \
                    ot[dvb] = __builtin_amdgcn_mfma_f32_32x32x16_bf16(cat8(VLO_[dvb], VHI_[dvb]), pf_, ot[dvb], 0, 0, 0); SB(); \
                    FILL_(dvb); \
                    if ((KS_) < 3) { NLO_[dvb] = tr16(vbase + vofs[dvb] + 4096 * ((KS_) + 1)); NHI_[dvb] = tr16(vbase + vofs[dvb] + 4096 * ((KS_) + 1) + 2048); } SB(); } } while (0)
            for (int kt = kt_lo; kt <= kt_hi; ++kt) {
                const int it = kt - kt_lo, sl = it & 3;
                const int ktn = AT_CLAMP(kt + 1);
                const bool leftn = (ktn * 64 + 63 <= qw0), rightn = (ktn * 64 >= qw0 + 31);
                const float sg = leftn ? slope2 : -slope2;
                const float LL = (leftn ? slope2 * (float)(ktn * 64 + 4 * h - qpos) : slope2 * (float)(qpos - ktn * 64 - 4 * h)) - Bi;
                AT_ISSUE(AT_CLAMP(kt + 3), (it + 3) & 3);
                const LAS unsigned char* kbase = lds + sl * SLOT + comp * 8192;
                const LAS unsigned char* vbase = lds + sl * SLOT + 16384;
                bf16x8 kf[8];
#pragma unroll
                for (int i = 0; i < 8; ++i) kf[i] = *(const LAS bf16x8*)(kbase + kofs[i & 3] + 4096 * (i >> 2));
                SB();
                s16x4 vlo[4], vhi[4], nlo[4], nhi[4];
                u32x4 pwa, pwb;
#pragma unroll
                for (int i = 0; i < 4; ++i) { sa[0] = __builtin_amdgcn_mfma_f32_32x32x16_bf16(kf[i], qf[i], sa[0], 0, 0, 0); SB();
                    vlo[i] = tr16(vbase + vofs[i]); vhi[i] = tr16(vbase + vofs[i] + 2048); SB(); }
                { float ee_[8];
#pragma unroll
                for (int i = 0; i < 4; ++i) { sa[1] = __builtin_amdgcn_mfma_f32_32x32x16_bf16(kf[4 + i], qf[i], sa[1], 0, 0, 0); SB();
                    AT_SMQ(pwa, sa[0], 0, i); SB(); } }
#define AT_FILL1(d_) AT_SMQ(pwb, sa[0], 8, d_)
#define AT_FILL2(d_) AT_SMQ(pwa, sa[1], 0, d_)
#define AT_FILL3(d_) AT_SMQ(pwb, sa[1], 8, d_)
                AT_PV_STAGE(0, vlo, vhi, pwa, nlo, nhi, AT_FILL1);
                AT_PV_STAGE(1, nlo, nhi, pwb, vlo, vhi, AT_FILL2);
                AT_PV_STAGE(2, vlo, vhi, pwa, nlo, nhi, AT_FILL3);
#define AT_FILL4(d_) do { _Pragma("unroll") for (int q_ = 0; q_ < 8; ++q_) { const int idx_ = 8 * (d_) + q_, blk_ = idx_ >> 4, reg_ = idx_ & 15; \
                    sa[blk_][reg_] = __builtin_fmaf(sg, (float)((reg_ & 3) + 8 * (reg_ >> 2) + 32 * blk_), LL); } asm volatile("" : "+v"(sa[(d_) >> 1])); } while (0)
                AT_PV_STAGE(3, nlo, nhi, pwb, vlo, vhi, AT_FILL4);
#undef AT_FILL1
#undef AT_FILL2
#undef AT_FILL3
#undef AT_FILL4
                if (!(leftn || rightn)) {
                    const float dq_ = (float)(qpos - ktn * 64 - 4 * h);
#pragma unroll
                    for (int blk = 0; blk < 2; ++blk)
#pragma unroll
                        for (int reg = 0; reg < 16; ++reg) sa[blk][reg] = -slope2 * __builtin_fabsf(dq_ - (float)((reg & 3) + 8 * (reg >> 2) + 32 * blk)) - Bi; }
                asm volatile("s_waitcnt vmcnt(8) lgkmcnt(0)" ::: "memory"); __builtin_amdgcn_s_barrier(); asm volatile("" ::: "memory");
            }
            asm volatile("s_waitcnt vmcnt(0)" ::: "memory"); __builtin_amdgcn_s_barrier(); asm volatile("" ::: "memory");
#undef AT_ISSUE
#undef AT_CLAMP
#undef SB
#undef AT_SMQ
#undef AT_PV_STAGE
#undef AT_CINIT
            const float la_ = __shfl(lacc[0], lane & 15), lb_ = __shfl(lacc[1], lane & 15);
            const float ltot = (r & 16) ? lb_ : la_;
            LAS float* X = (LAS float*)lds;
            if (comp == 1) { const float sc = lam / ltot;
#pragma unroll
                for (int dvb = 0; dvb < 4; ++dvb)
#pragma unroll
                    for (int reg = 0; reg < 16; ++reg) X[(qs * 64 + dvb * 16 + reg) * 64 + lane] = ot[dvb][reg] * sc; }
            __syncthreads();
            if (comp == 0) { const float inv = 1.f / ltot; float ss = 0.f;
#pragma unroll
                for (int dvb = 0; dvb < 4; ++dvb)
#pragma unroll
                    for (int reg = 0; reg < 16; ++reg) { const float o = ot[dvb][reg] * inv - X[(qs * 64 + dvb * 16 + reg) * 64 + lane]; ot[dvb][reg] = o; ss += o * o; }
                ss += __shfl_xor(ss, 32);
                const float rs = rsqrtf(ss * (1.f / 128.f) + RMS_EPS) * (1.f - lam_init);
                bf16_t* Orow = O + ((size_t)(b * SEQ + qpos)) * DM + hh * 128;
#pragma unroll
                for (int dvb = 0; dvb < 4; ++dvb)
#pragma unroll
                    for (int aa = 0; aa < 4; ++aa) { const int dv0 = 32 * dvb + 8 * aa + 4 * h; const f32x4 g4 = *(const f32x4*)(subg + dv0);
                        u32x2 w; w.x = pk2(ot[dvb][4 * aa + 0] * rs * g4.x, ot[dvb][4 * aa + 1] * rs * g4.y); w.y = pk2(ot[dvb][4 * aa + 2] * rs * g4.z, ot[dvb][4 * aa + 3] * rs * g4.w);
                        *(u32x2*)(Orow + dv0) = w; } }
            __syncthreads();
            if (tid == 0) lctl[0] = nidx;
        }
    }
}

#define XB_TMO      128
#define XB_XCNT(j)  (256  + 64 * (j))
#define XB_XSUB(j)  (1280 + 64 * (j))
#define XB_XGEN(j)  (2304 + 64 * (j))
#define XB_TOP      3328
#define XB_TOPGEN   3392
#define XCD_BAR_WORDS 3456
#define XB_SPIN_CAP (1u << 18)

__device__ __forceinline__ unsigned xb_ld(unsigned* p)              { return __hip_atomic_load(p, __ATOMIC_RELAXED, __HIP_MEMORY_SCOPE_AGENT); }
__device__ __forceinline__ unsigned xb_add(unsigned* p, unsigned v) { return __hip_atomic_fetch_add(p, v, __ATOMIC_RELAXED, __HIP_MEMORY_SCOPE_AGENT); }
__device__ __forceinline__ unsigned xb_xcc_id() { return (unsigned)__builtin_amdgcn_s_getreg((3 << 11) | 20) & 0xFu; }
#define XB_SPIN(cond, bar) do { unsigned _sp = 0; while (cond) { __builtin_amdgcn_s_sleep(1); \
    if ((++_sp & 255u) == 0u) { if (xb_ld(&(bar)[XB_TMO])) break; if (_sp > XB_SPIN_CAP) { atomicAdd(&(bar)[XB_TMO], 1u); break; } } } } while (0)

struct XcdBarrier {
    unsigned* bar; unsigned x;
    volatile LAS unsigned* st;
};

__device__ __forceinline__ XcdBarrier xcd_barrier_post(unsigned* bar, volatile LAS unsigned* st) {
    XcdBarrier b; b.bar = bar; b.x = xb_xcc_id(); b.st = st;
    if (threadIdx.x == 0) (void)xb_add(&bar[XB_XCNT(b.x)], 1u);
    return b;
}
__device__ __forceinline__ void xcd_barrier_complete(unsigned* bar, unsigned x, unsigned& nloc, unsigned& nx) {
    const unsigned G = gridDim.x * gridDim.y * gridDim.z;
    unsigned sum, cnt, mine, sp = 0u;
    for (;;) {
        sum = 0u; cnt = 0u; mine = 0u;
#pragma unroll
        for (unsigned j = 0; j < 16; ++j) { const unsigned c = xb_ld(&bar[XB_XCNT(j)]); sum += c; cnt += (c > 0u) ? 1u : 0u; mine = (j == x) ? c : mine; }
        if (sum == G) break;
        __builtin_amdgcn_s_sleep(1);
        if ((++sp & 255u) == 0u) { if (xb_ld(&bar[XB_TMO])) break; if (sp > XB_SPIN_CAP) { atomicAdd(&bar[XB_TMO], 1u); break; } }
    }
    nloc = mine > 0u ? mine : 1u; nx = cnt > 0u ? cnt : 1u;
}

__device__ __forceinline__ void xcd_barrier(const XcdBarrier& b) {
    asm volatile("s_waitcnt vmcnt(0)" ::: "memory");
    __syncthreads();
    if (threadIdx.x == 0) {
        unsigned* bar = b.bar;
        __builtin_amdgcn_s_waitcnt(0);
        unsigned nloc = b.st[0], nx = b.st[1];
        if (nloc == 0u) { xcd_barrier_complete(bar, b.x, nloc, nx); b.st[0] = nloc; b.st[1] = nx; }
        const unsigned old = xb_add(&bar[XB_XSUB(b.x)], 1u);
        const unsigned gen = old / nloc;
        if (old + 1u == (gen + 1u) * nloc) {
            __builtin_amdgcn_fence(__ATOMIC_RELEASE, "agent");
            asm volatile("s_waitcnt vmcnt(0)" ::: "memory");
            const unsigned og = xb_add(&bar[XB_TOP], 1u);
            const unsigned tg = og / nx;
            if (og + 1u == (tg + 1u) * nx) xb_add(&bar[XB_TOPGEN], 1u);
            else XB_SPIN(xb_ld(&bar[XB_TOPGEN]) == tg, bar);
            __builtin_amdgcn_fence(__ATOMIC_ACQUIRE, "agent");
            xb_add(&bar[XB_XGEN(b.x)], 1u);
            asm volatile("s_waitcnt vmcnt(0)" ::: "memory");
        } else {
            XB_SPIN(xb_ld(&bar[XB_XGEN(b.x)]) == gen, bar);
            __builtin_amdgcn_fence(__ATOMIC_ACQUIRE, "agent");
            asm volatile("s_waitcnt vmcnt(0)" ::: "memory");
        }
    }
    __syncthreads();
}

__global__ void __launch_bounds__(512, 2) mega_fwd(Args a_) {
    extern __shared__ __attribute__((aligned(16))) unsigned char lds_raw[];
    LAS unsigned char* lds = (LAS unsigned char*)lds_raw;
    cg::grid_group grid = cg::this_grid();
    if (threadIdx.x < 64) ((LAS unsigned*)(lds + 131072))[threadIdx.x] = 0u;
    __syncthreads();
    (void)xcd_barrier_post((unsigned*)(a_.ws + WS_CTL) + 4096, (volatile LAS unsigned*)(lds + 131072 + 64));
        const int G = gridDim.x;
#ifndef PROBE_MASK
#define PROBE_MASK 0
#endif
    for (int ph = a_.ph_lo; ph < a_.ph_hi; ++ph) {
      CArgs* ap = (CArgs*)__builtin_amdgcn_kernarg_segment_ptr(); asm volatile("" : "+s"(ap)); CArgs& a = *ap;
      unsigned char* ws = a.ws;
      const int nrep = ((PROBE_MASK >> ph) & 1) ? 2 : 1;
      for (int rep = 0; rep < nrep; ++rep) {
        if (0) {}
#if !defined(PHM) || (PHM & 1)
        else if (ph == 0) { phase_prologue(a, lds, G); phase_fft1(a, lds, G); }
#endif
#if !defined(PHM) || (PHM & 2)
        else if (ph == 1) { }
#endif
#if !defined(PHM) || (PHM & 4)
        else if (ph == 2) phase_fft2(a, lds, G);
#endif
#if !defined(PHM) || (PHM & 8)
        else if (ph == 9) { }
        else if (ph == 10) phase_attn(a, lds, G, rep);
#endif
#if !defined(PHM) || (PHM & 16)
        else if (ph == 3) {
            pg8::Gemm g{(const bf16_t*)(ws + WS_A), (const bf16_t*)(ws + WS_WF), 2 * MH, 2 * DM, DM}; pg8::StackedOrder S{G, (int)blockIdx.x};
            pg8::EpiBf16 E{(bf16_t*)(ws + WS_U), DM, DM, 0, 1.f, nullptr, nullptr};
            pg8::gemm_phase<pg8::EpiBf16, pg8::StackedOrder, true, true>(lds, g, S, E);
        }
        else if (ph == 6 || ph == 11 || ph == 14) {
            const bf16_t* A; const bf16_t* Bt; int K;
            if (ph == 11) { A = (const bf16_t*)(ws + WS_O); Bt = (const bf16_t*)(ws + WS_WDO); K = DM; }
            else { A = (const bf16_t*)(ws + WS_HFF); Bt = (const bf16_t*)(ws + (ph == 6 ? WS_WDN0 : WS_WDN1)); K = DFF; }
            pg8::Gemm g{A, Bt, MTOK, DM, K}; pg8::StaticOrder S; S.init(MTOK, DM, G, (int)blockIdx.x);
            pg8::EpiBf16Ssq E{(bf16_t*)(ws + WS_MB), DM, (float*)(ws + WS_SSQ)};
            pg8::gemm_phase<pg8::EpiBf16Ssq, pg8::StaticOrder, true, true>(lds, g, S, E);
        }
#endif
#if !defined(PHM) || (PHM & 32)
        else if (ph == 5 || ph == 13) {
            pg8::Gemm g{(const bf16_t*)(ws + WS_HB), (const bf16_t*)(ws + (ph == 5 ? WS_WGU0 : WS_WGU1)), MTOK, 2 * DFF, DM}; pg8::StaticOrder S; S.init(MTOK, 2 * DFF, G, (int)blockIdx.x);
            pg8::EpiSwiglu E{(bf16_t*)(ws + WS_HFF), DFF, (const float*)(ws + WS_RSB)};
            pg8::gemm_phase<pg8::EpiSwiglu, pg8::StaticOrder, true, true>(lds, g, S, E);
        }
#endif
#if !defined(PHM) || (PHM & 64)
        else if (ph == 8) {
            pg8::Gemm g{(const bf16_t*)(ws + WS_HB), (const bf16_t*)(ws + WS_WQKV), MTOK, 3 * DM, DM}; pg8::StaticOrder S; S.init(MTOK, 3 * DM, G, (int)blockIdx.x);
            pg8::EpiBf16 E{(bf16_t*)(ws + WS_Q), DM, DM, (size_t)(WS_K - WS_Q) / 2, 0.125f * 1.4426950408889634f, (const float*)(ws + WS_RSB), (unsigned*)(ws + WS_CTL) + 256};
            pg8::gemm_phase<pg8::EpiBf16, pg8::StaticOrder, true, true>(lds, g, S, E);
        }
#endif
        else {
            const int l = (ph >= 12) ? 1 : 0; const bool mix = (ph == 4 || ph == 12);
            const float* gpost = (mix ? a.in[2] : a.in[4]) + l * DM;
            const float* gnext = (ph == 15) ? nullptr : (ph == 7 ? a.in[1] + DM : a.in[3] + l * DM);
            bf16_t* hb = (bf16_t*)(ws + WS_HB);
            if (ph == 4) phase_ew_fourier(a.in[0], (const bf16_t*)(ws + WS_U), gpost, gnext, hb, (bf16_t*)(ws + WS_RSB), G);
            else if (ph == 15) phase_ew<true, true>(hb, (const bf16_t*)(ws + WS_MB), (const float*)(ws + WS_SSQ), gpost, gnext, a.out, (bf16_t*)(ws + WS_RSB), G);
            else phase_ew<true, false>(hb, (const bf16_t*)(ws + WS_MB), (const float*)(ws + WS_SSQ), gpost, gnext, hb, (bf16_t*)(ws + WS_RSB), G);
        }
      }
        if (ph + 1 < a_.ph_hi && ph != 9 && ph != 0) { if (ph == 1000) grid.sync(); else { XcdBarrier b_; b_.bar = (unsigned*)(a.ws + WS_CTL) + 4096; b_.x = xb_xcc_id(); b_.st = (volatile LAS unsigned*)(lds + 131072 + 64); xcd_barrier(b_); } }
    }
}

#ifndef MK_ONE_LAUNCH
#define MK_ONE_LAUNCH 1
#endif
extern "C" void kernel_launch(void* const* d_in, const int* in_sizes, int n_in, void* d_out, int out_size, void* d_ws, size_t ws_size, hipStream_t stream) {
    static int grid = 0;
    if (grid == 0) {
        if (n_in != 16 || in_sizes[0] != MTOK * DM || out_size != MTOK * DM || ws_size < WS_END) { fprintf(stderr, "kernel_launch: unexpected shapes (n_in %d, ws %zu)\n", n_in, ws_size); grid = -1; return; }
        int dev = 0, cus = 0, per_cu = 0;
        hipGetDevice(&dev); hipDeviceGetAttribute(&cus, hipDeviceAttributeMultiprocessorCount, dev);
        hipFuncSetAttribute((const void*)mega_fwd, hipFuncAttributeMaxDynamicSharedMemorySize, LDS_BYTES);
        if (hipOccupancyMaxActiveBlocksPerMultiprocessor(&per_cu, (const void*)mega_fwd, 512, LDS_BYTES) != hipSuccess || per_cu < 1) per_cu = 1;
        (void)hipGetLastError();
        grid = cus * per_cu;
    }
    if (grid < 0) return;
    Args a{};
    for (int i = 0; i < 16; ++i) a.in[i] = (const float*)d_in[i];
    a.out = (float*)d_out; a.ws = (unsigned char*)d_ws;
    if (hipMemsetAsync((char*)d_ws + WS_CTL, 0, 65536, stream) != hipSuccess) { fprintf(stderr, "memset failed\n"); return; }
#if MK_ONE_LAUNCH
    a.ph_lo = 0; a.ph_hi = NPHASE;
    { void* args[] = {&a}; hipError_t e = hipLaunchCooperativeKernel((const void*)mega_fwd, dim3(grid), dim3(512), args, LDS_BYTES, stream);
      if (e != hipSuccess) fprintf(stderr, "cooperative launch failed: %s (grid %d)\n", hipGetErrorString(e), grid); }
#else
    for (int ph = 0; ph < NPHASE; ++ph) { a.ph_lo = ph; a.ph_hi = ph + 1; void* args[] = {&a};
        hipError_t e = hipLaunchCooperativeKernel((const void*)mega_fwd, dim3(grid), dim3(512), args, LDS_BYTES, stream);
        if (e != hipSuccess) { fprintf(stderr, "launch %d failed: %s\n", ph, hipGetErrorString(e)); break; } }
#endif
}
```

```cpp
#include <hip/hip_runtime.h>
#include <hip/hip_cooperative_groups.h>
#include <cstdio>
#include <cstdint>
namespace cg = cooperative_groups;
namespace pg8 {
#define PG8_LAS __attribute__((address_space(3)))
typedef unsigned short bf16_t;
typedef short bf16x8 __attribute__((ext_vector_type(8)));
typedef float f32x4 __attribute__((ext_vector_type(4)));
typedef unsigned u32x4 __attribute__((ext_vector_type(4)));
constexpr int BM = 256, BK = 64, HALF = 128, HTB = HALF * BK * 2  , STAGE_BYTES = 8 * HTB, NXCD = 8, WGM = 8;

__host__ __device__ __forceinline__ int lds_byte(int r, int c) { const int st = (r >> 4) * 2 + (c >> 5), rr = r & 15, cc = c & 31, ob = rr * 64 + cc * 2; return st * 1024 + (ob ^ (((ob >> 9) & 1) << 5)); }
__host__ __device__ __forceinline__ void stage_rc(int b, int& R, int& C) { const int st = b / 1024, sb = b % 1024, swz = sb ^ (((sb >> 9) & 1) << 5); R = (st >> 1) * 16 + swz / 64; C = (st & 1) * 32 + (swz % 64) / 2; }
__host__ __device__ __forceinline__ int perm32(int rho) { const int n = rho >> 4, i = rho & 15; return 8 * (i >> 2) + 4 * n + (i & 3); }

struct Unit { int pm, pn; };
struct Gemm { const bf16_t* A; const bf16_t* Bt; int M, N, K; };

struct StaticOrder {
    int nM, nN, nwg, G, c;
    __host__ __device__ void init(int M, int N, int G_, int c_) { nM = M / BM; nN = N / BM; nwg = nM * nN; G = G_; c = c_; }
    __host__ __device__ bool next(int i, Unit& u) const {
        const long L = (long)i * G + c; if (L >= nwg) return false;
        int wgid = (int)L; { const int q = nwg / NXCD, r = nwg % NXCD, xcd = wgid % NXCD, off = wgid / NXCD; wgid = (xcd < r ? xcd * (q + 1) : r * (q + 1) + (xcd - r) * q) + off; }
        const int nig = WGM * nN, gid = wgid / nig, fm = gid * WGM, gsz = (nM - fm) < WGM ? (nM - fm) : WGM;
        u.pm = fm + ((wgid % nig) % gsz); u.pn = (wgid % nig) / gsz; return true;
    }
    __device__ __forceinline__ void a_ready(const Unit&) const {}
    __device__ __forceinline__ void done(const Unit&) const {}
};

__device__ __forceinline__ unsigned cvt_pk_bf16(float lo, float hi) { unsigned r; asm volatile("v_cvt_pk_bf16_f32 %0, %1, %2" : "=v"(r) : "v"(lo), "v"(hi)); return r; }
struct EpiBf16 {
    static constexpr bool PERM = true, AFTER_DRAIN = false;
    bf16_t* O; int ldc; int split_cols; size_t split_stride; float scale0;
    const float* rowscale;
    unsigned* kmaxh;
    __device__ __forceinline__ void operator()(const f32x4 (&acc)[2][2][4][2], const Unit& u, int wr, int wc, int fr, int fq) const {
        const int row0 = u.pm * BM + wr * 64 + fr; int colt = u.pn * BM; bf16_t* base = O;
        float sc = 1.f; int t = 0; if (split_cols) { t = colt / split_cols; base += (size_t)t * split_stride; colt -= t * split_cols; if (t == 0) sc = scale0; }
        const int col0 = colt + wc * 32 + 8 * fq;
        float mx[2] = {0.f, 0.f};
#pragma unroll
        for (int ai = 0; ai < 2; ++ai)
#pragma unroll
            for (int m = 0; m < 4; ++m) { bf16_t* rowp = base + (size_t)(row0 + ai * HALF + m * 16) * ldc + col0; const float scr_ = rowscale ? sc * rowscale[row0 + ai * HALF + m * 16] : sc;
#pragma unroll
                for (int bj = 0; bj < 2; ++bj) { f32x4 v0 = acc[ai][bj][m][0] * scr_, v1 = acc[ai][bj][m][1] * scr_;
                    u32x4 w; w.x = cvt_pk_bf16(v0[0], v0[1]); w.y = cvt_pk_bf16(v0[2], v0[3]); w.z = cvt_pk_bf16(v1[0], v1[1]); w.w = cvt_pk_bf16(v1[2], v1[3]);
                    *(u32x4*)(rowp + bj * HALF) = w;
                    if (kmaxh && t == 1) { float s = 0.f;
#pragma unroll
                        for (int e = 0; e < 4; ++e) { const float lo = __builtin_bit_cast(float, w[e] << 16), hi = __builtin_bit_cast(float, w[e] & 0xffff0000u); s += lo * lo + hi * hi; }
                        s += __shfl_xor(s, 16); s += __shfl_xor(s, 32);
                        mx[bj] = __builtin_fmaxf(mx[bj], s); } } }
        if (kmaxh && t == 1) {
#pragma unroll
            for (int bj = 0; bj < 2; ++bj) { float v = mx[bj]; v = __builtin_fmaxf(v, __shfl_xor(v, 1)); v = __builtin_fmaxf(v, __shfl_xor(v, 2)); v = __builtin_fmaxf(v, __shfl_xor(v, 4)); v = __builtin_fmaxf(v, __shfl_xor(v, 8));
                if (fr == 0 && fq == 0) atomicMax(kmaxh + (((u.pm >> 5) * 16 + (colt >> 6) + 2 * bj + (wc >> 1)) * 2 + (wc & 1)), __builtin_bit_cast(unsigned, v)); } }
    }
};
struct EpiBf16Ssq {
    static constexpr bool PERM = true, AFTER_DRAIN = false;
    bf16_t* O; int ldc; float* ssq;
    __device__ __forceinline__ void operator()(const f32x4 (&acc)[2][2][4][2], const Unit& u, int wr, int wc, int fr, int fq) const {
        const int row0 = u.pm * BM + wr * 64 + fr; const int col0 = u.pn * BM + wc * 32 + 8 * fq;
#pragma unroll
        for (int ai = 0; ai < 2; ++ai)
#pragma unroll
            for (int m = 0; m < 4; ++m) { const size_t row = (size_t)(row0 + ai * HALF + m * 16); bf16_t* rowp = O + row * ldc + col0; float s = 0.f;
#pragma unroll
                for (int bj = 0; bj < 2; ++bj) { const f32x4 v0 = acc[ai][bj][m][0], v1 = acc[ai][bj][m][1];
                    s += (v0[0] * v0[0] + v0[1] * v0[1]) + (v0[2] * v0[2] + v0[3] * v0[3]) + (v1[0] * v1[0] + v1[1] * v1[1]) + (v1[2] * v1[2] + v1[3] * v1[3]);
                    u32x4 w; w.x = cvt_pk_bf16(v0[0], v0[1]); w.y = cvt_pk_bf16(v0[2], v0[3]); w.z = cvt_pk_bf16(v1[0], v1[1]); w.w = cvt_pk_bf16(v1[2], v1[3]);
                    *(u32x4*)(rowp + bj * HALF) = w; }
                s += __shfl_xor(s, 16); s += __shfl_xor(s, 32);
                if (fq == 0) ssq[row * 16 + u.pn * 4 + wc] = s; }
    }
};
__device__ __forceinline__ float silu_mul(float g, float u) { return g * __builtin_amdgcn_rcpf(1.f + __builtin_amdgcn_exp2f(-1.4426950408889634f * g)) * u; }
struct EpiSwiglu {
    static constexpr bool PERM = true, AFTER_DRAIN = false;
    bf16_t* O; int ldc; const float* rowscale;
    __device__ __forceinline__ void operator()(const f32x4 (&acc)[2][2][4][2], const Unit& u, int wr, int wc, int fr, int fq) const {
        const int row0 = u.pm * BM + wr * 64 + fr; const int col0 = u.pn * 128 + wc * 16 + 4 * fq;
        typedef unsigned u32x2 __attribute__((ext_vector_type(2)));
#pragma unroll
        for (int ai = 0; ai < 2; ++ai)
#pragma unroll
            for (int m = 0; m < 4; ++m) { bf16_t* rowp = O + (size_t)(row0 + ai * HALF + m * 16) * ldc + col0; const float rs_ = rowscale[row0 + ai * HALF + m * 16];
#pragma unroll
                for (int bj = 0; bj < 2; ++bj) { const f32x4 v0 = acc[ai][bj][m][0] * rs_, v1 = acc[ai][bj][m][1] * rs_;
                    u32x2 w; w.x = cvt_pk_bf16(silu_mul(v0[0], v0[1]), silu_mul(v0[2], v0[3])); w.y = cvt_pk_bf16(silu_mul(v1[0], v1[1]), silu_mul(v1[2], v1[3]));
                    *(u32x2*)(rowp + bj * 64) = w; } }
    }
};

struct StackedOrder {
    int G, c;
    __device__ __forceinline__ bool next(int i, Unit& u) const { const long L = (long)i * G + c; if (L >= 1056) return false; u.pm = (int)(L >> 2); u.pn = (int)(L & 3) + (u.pm >= 132 ? 4 : 0); return true; }
    __device__ __forceinline__ void a_ready(const Unit&) const {}
    __device__ __forceinline__ void done(const Unit&) const {}
};
template <class Epi, class Sched, bool ALIGN_EPI = false, bool SP2 = false>
__device__ __forceinline__ void gemm_phase(PG8_LAS unsigned char* lds, const Gemm g, const Sched& S, const Epi& E) {
    int tid_ = threadIdx.x; asm volatile("" : "+v"(tid_)); const int tid = tid_, wid = __builtin_amdgcn_readfirstlane(tid >> 6), lane = tid & 63, wr = wid >> 2, wc = wid & 3, fr = lane & 15, fq = lane >> 4;
    const int K = g.K, nt = K / BK;
    unsigned voffA[2], voffB[2];
#pragma unroll
    for (int i = 0; i < 2; ++i) { int R, C; stage_rc(tid * 16 + i * 8192, R, C); const int Rb = Epi::PERM ? ((R & ~31) + perm32(R & 31)) : R;
        voffA[i] = (unsigned)(R * K + C) * 2u; voffB[i] = (unsigned)(Rb * K + C) * 2u; }
    const size_t kstep = (size_t)(BK * 2);
    const size_t hstep = (size_t)HALF * K * 2;
    const size_t tstep = 2 * hstep;
    const unsigned ldsw = (unsigned)wid * 1024u;
    const int aoff = lds_byte(wr * 64 + fr, fq * 8), boff = lds_byte(wc * 32 + fr, fq * 8);
#define PG8_SA(b, h) (((b) * 2 + (h)) * HTB)
#define PG8_SB(b, h) ((4 + (b) * 2 + (h)) * HTB)
#define PG8_STAGE(bufoff, gbase, voff) do { _Pragma("unroll") for (int _i = 0; _i < 2; ++_i) \
        __builtin_amdgcn_global_load_lds((const unsigned*)((const char*)(gbase) + (voff)[_i]), (PG8_LAS unsigned*)(lds + (bufoff) + ldsw + _i * 8192), 16, 0, 0); } while (0)
#define PG8_LDA(dst, b, h) do { _Pragma("unroll") for (int m = 0; m < 4; ++m) _Pragma("unroll") for (int k = 0; k < 2; ++k) dst[m][k] = *(const PG8_LAS bf16x8*)(lds + PG8_SA(b, h) + aoff + m * 2048 + k * 1024); } while (0)
#define PG8_LDB(dst, b, h) do { _Pragma("unroll") for (int n = 0; n < 2; ++n) _Pragma("unroll") for (int k = 0; k < 2; ++k) dst[n][k] = *(const PG8_LAS bf16x8*)(lds + PG8_SB(b, h) + boff + n * 2048 + k * 1024); } while (0)
#define PG8_MMA(ai, bj, At, Bt) do { __builtin_amdgcn_s_setprio(1); _Pragma("unroll") for (int m = 0; m < 4; ++m) _Pragma("unroll") for (int n = 0; n < 2; ++n) _Pragma("unroll") for (int k = 0; k < 2; ++k) \
        acc[ai][bj][m][n] = __builtin_amdgcn_mfma_f32_16x16x32_bf16(Bt[n][k], At[m][k], acc[ai][bj][m][n], 0, 0, 0); __builtin_amdgcn_s_setprio(0); } while (0)
#define PG8_WAIT_V(n) asm volatile("s_waitcnt vmcnt(" #n ")" ::: "memory")
#define PG8_WAIT_L(n) asm volatile("s_waitcnt lgkmcnt(" #n ")" ::: "memory")
#define PG8_BAR __builtin_amdgcn_s_barrier()
#define PG8_SCHED __builtin_amdgcn_sched_barrier(0)
    Unit cur, nxt; int ui = 0;
    if (!S.next(0, cur)) return;
    f32x4 acc[2][2][4][2];
#pragma unroll
    for (int a = 0; a < 2; ++a)
#pragma unroll
        for (int b = 0; b < 2; ++b)
#pragma unroll
            for (int m = 0; m < 4; ++m)
#pragma unroll
                for (int n = 0; n < 2; ++n) acc[a][b][m][n] = (f32x4){0.f, 0.f, 0.f, 0.f};
    bf16x8 At[4][2], B0[2][2], B1[2][2];
    const char* cA = (const char*)g.A + (size_t)cur.pm * tstep; const char* cB = (const char*)g.Bt + (size_t)cur.pn * tstep;
    S.a_ready(cur);
    if constexpr (SP2) {
        PG8_STAGE(PG8_SB(0, 0), cB, voffB); PG8_STAGE(PG8_SB(0, 1), cB + hstep, voffB); PG8_STAGE(PG8_SA(0, 0), cA, voffA); PG8_STAGE(PG8_SA(0, 1), cA + hstep, voffA);
        if (wr == 1) PG8_BAR;
        PG8_WAIT_V(2); PG8_BAR;
        PG8_STAGE(PG8_SB(1, 0), cB + kstep, voffB); PG8_STAGE(PG8_SA(1, 0), cA + kstep, voffA); PG8_STAGE(PG8_SB(1, 1), cB + hstep + kstep, voffB);
        PG8_WAIT_V(6); PG8_BAR;
    } else {
        PG8_STAGE(PG8_SB(0, 0), cB, voffB); PG8_STAGE(PG8_SA(0, 0), cA, voffA); PG8_STAGE(PG8_SB(0, 1), cB + hstep, voffB); PG8_STAGE(PG8_SA(0, 1), cA + hstep, voffA);
        if (wr == 1) PG8_BAR;
        PG8_WAIT_V(4); PG8_BAR;
        PG8_STAGE(PG8_SB(1, 0), cB + kstep, voffB); PG8_STAGE(PG8_SA(1, 0), cA + kstep, voffA); PG8_STAGE(PG8_SB(1, 1), cB + hstep + kstep, voffB);
        PG8_WAIT_V(6); PG8_BAR;
    }
    for (;;) {
        const bool has_next = S.next(ui + 1, nxt);
        const char* nA = has_next ? (const char*)g.A + (size_t)nxt.pm * tstep : cA; const char* nB = has_next ? (const char*)g.Bt + (size_t)nxt.pn * tstep : cB;
        for (int t = 0; t < nt; t += 2) {
            const bool last = (t == nt - 2);
            const char* a1 = cA + (size_t)(t + 1) * kstep;
            const char* a2 = last ? nA : cA + (size_t)(t + 2) * kstep; const char* b2 = last ? nB : cB + (size_t)(t + 2) * kstep;
            const char* a3 = a2 + kstep; const char* b3 = b2 + kstep;
            if (last && has_next) S.a_ready(nxt);
            if constexpr (SP2) {
            PG8_LDB(B0, 0, 0); PG8_LDB(B1, 0, 1); PG8_SCHED; PG8_LDA(At, 0, 0); PG8_STAGE(PG8_SA(1, 1), a1 + hstep, voffA);
            PG8_WAIT_V(8); PG8_WAIT_L(0); PG8_BAR; PG8_MMA(0, 0, At, B0); PG8_MMA(0, 1, At, B1); PG8_BAR; PG8_SCHED;
            PG8_LDA(At, 0, 1); PG8_STAGE(PG8_SB(0, 0), b2, voffB); PG8_STAGE(PG8_SB(0, 1), b2 + hstep, voffB); PG8_STAGE(PG8_SA(0, 0), a2, voffA);
            PG8_WAIT_V(8); PG8_WAIT_L(0); PG8_BAR; PG8_MMA(1, 0, At, B0); PG8_MMA(1, 1, At, B1); PG8_BAR; PG8_SCHED;
            PG8_LDB(B0, 1, 0); PG8_LDB(B1, 1, 1); PG8_SCHED; PG8_LDA(At, 1, 0); PG8_STAGE(PG8_SA(0, 1), a2 + hstep, voffA);
            PG8_WAIT_V(8); PG8_WAIT_L(0); PG8_BAR; PG8_MMA(0, 0, At, B0); PG8_MMA(0, 1, At, B1); PG8_BAR; PG8_SCHED;
            PG8_LDA(At, 1, 1); PG8_STAGE(PG8_SB(1, 0), b3, voffB); PG8_STAGE(PG8_SB(1, 1), b3 + hstep, voffB); PG8_STAGE(PG8_SA(1, 0), a3, voffA);
            PG8_WAIT_V(8); PG8_WAIT_L(0); PG8_BAR; PG8_MMA(1, 0, At, B0); PG8_MMA(1, 1, At, B1); PG8_BAR; PG8_SCHED;
            } else {
            PG8_LDB(B0, 0, 0); PG8_SCHED; PG8_LDA(At, 0, 0); PG8_STAGE(PG8_SA(1, 1), a1 + hstep, voffA);
            PG8_WAIT_L(8); PG8_BAR; PG8_WAIT_L(0); PG8_MMA(0, 0, At, B0); PG8_BAR; PG8_SCHED;
            PG8_LDB(B1, 0, 1); PG8_STAGE(PG8_SB(0, 0), b2, voffB);
            PG8_BAR; PG8_WAIT_L(0); PG8_MMA(0, 1, At, B1); PG8_BAR;
            PG8_LDA(At, 0, 1); PG8_STAGE(PG8_SA(0, 0), a2, voffA);
            PG8_BAR; PG8_WAIT_L(0); PG8_MMA(1, 0, At, B0); PG8_BAR; PG8_SCHED;
            PG8_STAGE(PG8_SB(0, 1), b2 + hstep, voffB);
            PG8_WAIT_V(6); PG8_BAR; PG8_MMA(1, 1, At, B1); PG8_BAR;
            PG8_LDB(B0, 1, 0); PG8_SCHED; PG8_LDA(At, 1, 0); PG8_STAGE(PG8_SA(0, 1), a2 + hstep, voffA);
            PG8_WAIT_L(8); PG8_BAR; PG8_WAIT_L(0); PG8_MMA(0, 0, At, B0); PG8_BAR; PG8_SCHED;
            PG8_LDB(B1, 1, 1); PG8_STAGE(PG8_SB(1, 0), b3, voffB);
            PG8_BAR; PG8_WAIT_L(0); PG8_MMA(0, 1, At, B1); PG8_BAR;
            PG8_LDA(At, 1, 1); PG8_STAGE(PG8_SA(1, 0), a3, voffA);
            PG8_BAR; PG8_WAIT_L(0); PG8_MMA(1, 0, At, B0); PG8_BAR; PG8_SCHED;
            PG8_STAGE(PG8_SB(1, 1), b3 + hstep, voffB);
            PG8_WAIT_V(6); PG8_BAR; PG8_MMA(1, 1, At, B1); PG8_BAR;
            }
        }
        if constexpr (ALIGN_EPI) { if (wr == 0) PG8_BAR; }
        if constexpr (!Epi::AFTER_DRAIN) { E(acc, cur, wr, wc, fr, fq); S.done(cur); }
        if (!has_next) break;
#pragma unroll
        for (int a = 0; a < 2; ++a)
#pragma unroll
            for (int b = 0; b < 2; ++b)
#pragma unroll
                for (int m = 0; m < 4; ++m)
#pragma unroll
                    for (int n = 0; n < 2; ++n) acc[a][b][m][n] = (f32x4){0.f, 0.f, 0.f, 0.f};
        cur = nxt; cA = nA; cB = nB; ++ui;
        if constexpr (ALIGN_EPI) { if (wr == 1) PG8_BAR; }
    }
    PG8_WAIT_V(0);
    if constexpr (!ALIGN_EPI) { if (wr == 0) PG8_BAR; }
    PG8_BAR;
    if constexpr (Epi::AFTER_DRAIN) { E.fused(acc, cur, wr, wc, fr, fq, lds, wid, lane); S.done(cur); }
#undef PG8_SA
#undef PG8_SB
#undef PG8_STAGE
#undef PG8_LDA
#undef PG8_LDB
#undef PG8_MMA
#undef PG8_WAIT_V
#undef PG8_WAIT_L
#undef PG8_BAR
#undef PG8_SCHED
}
}
using pg8::bf16_t;
#define LAS __attribute__((address_space(3)))
typedef unsigned u32x4 __attribute__((ext_vector_type(4)));
typedef unsigned u32x2 __attribute__((ext_vector_type(2)));
typedef float f32x4 __attribute__((ext_vector_type(4)));
typedef float f32x2 __attribute__((ext_vector_type(2)));
typedef float f32x16 __attribute__((ext_vector_type(16)));
typedef short bf16x8 __attribute__((ext_vector_type(8)));
typedef short s16x4 __attribute__((ext_vector_type(4)));

constexpr int NBATCH = 8, SEQ = 8192, DM = 1024, MTOK = NBATCH * SEQ, DFF = 2816;
constexpr float RMS_EPS = 1e-6f;
constexpr size_t MiB = 1u << 20;
constexpr size_t WS_WQKV = 0, WS_WDO = 6 * MiB, WS_WF = 8 * MiB, WS_WGU0 = 12 * MiB, WS_WGU1 = 23 * MiB, WS_WDN0 = 34 * MiB, WS_WDN1 = 40 * MiB,
    WS_F1 = 46 * MiB, WS_F2 = 47 * MiB, WS_TW = 48 * MiB, WS_CTL = 49 * MiB, WS_RSB = 58 * MiB, WS_SSQ = 50 * MiB, WS_XN = 64 * MiB, WS_U = 192 * MiB, WS_A = 448 * MiB, WS_MB = 704 * MiB,
    WS_HFF = 192 * MiB, WS_Q = 192 * MiB, WS_K = 320 * MiB, WS_V = 448 * MiB, WS_O = 576 * MiB, WS_HB = 832 * MiB, WS_END = 960 * MiB;
constexpr int LDS_BYTES = 143360;
constexpr int NPHASE = 16;
constexpr int MH = NBATCH * 33 * 128, NB_F2 = NBATCH * 33 * 8;

__device__ __forceinline__ unsigned f2bf(float f) { unsigned u = __builtin_bit_cast(unsigned, f); return (u + 0x7fffu + ((u >> 16) & 1u)) >> 16; }
typedef __bf16 bf16x2_t __attribute__((ext_vector_type(2)));
__device__ __forceinline__ unsigned pk2(float lo, float hi) { const f32x2 v = {lo, hi}; const bf16x2_t b = __builtin_convertvector(v, bf16x2_t); return __builtin_bit_cast(unsigned, b); }
__device__ __forceinline__ float bf_lo(unsigned w) { return __builtin_bit_cast(float, w << 16); }
__device__ __forceinline__ float bf_hi(unsigned w) { return __builtin_bit_cast(float, w & 0xffff0000u); }
__device__ __forceinline__ float dpp_f(float v, int ctrl_sel) {
    const int x = __builtin_bit_cast(int, v); int r;
    if (ctrl_sel == 0) r = __builtin_amdgcn_mov_dpp(x, 0xB1, 0xF, 0xF, true);
    else if (ctrl_sel == 1) r = __builtin_amdgcn_mov_dpp(x, 0x4E, 0xF, 0xF, true);
    else if (ctrl_sel == 2) r = __builtin_amdgcn_mov_dpp(x, 0x141, 0xF, 0xF, true);
    else r = __builtin_amdgcn_mov_dpp(x, 0x140, 0xF, 0xF, true);
    return __builtin_bit_cast(float, r);
}
__device__ __forceinline__ float row16_sum(float v) { v += dpp_f(v, 0); v += dpp_f(v, 1); v += dpp_f(v, 2); v += dpp_f(v, 3); return v; }
__device__ __forceinline__ float wave_sum(float v) { v = row16_sum(v); v += __shfl_xor(v, 16); v += __shfl_xor(v, 32); return v; }
__device__ __forceinline__ s16x4 tr16(const LAS unsigned char* p) {
    typedef short v4i16_t __attribute__((ext_vector_type(4)));
    return __builtin_bit_cast(s16x4, __builtin_amdgcn_ds_read_tr16_b64_v4i16((LAS v4i16_t*)p));
}
__device__ __forceinline__ bf16x8 cat8(s16x4 lo, s16x4 hi) { return (bf16x8){lo[0], lo[1], lo[2], lo[3], hi[0], hi[1], hi[2], hi[3]}; }
#define LDS_WAIT() asm volatile("s_waitcnt lgkmcnt(0)" ::: "memory")

struct Args { const float* in[16]; float* out; unsigned char* ws; int ph_lo, ph_hi; };
typedef const __attribute__((address_space(4))) Args CArgs;

__device__ __forceinline__ int idx_next(int idx, int step) { int t = idx + step; asm volatile("" : "+v"(t)); return t; }
__device__ __forceinline__ void p0_transpose_item(const float* W, int K, int N, bf16_t* WT, int rmul, int radd, LAS float* scr, int item, int lane, const float* gain) {
    const int nblk = N / 32, kb = item / nblk, nb = item % nblk, k0 = 64 * kb, n0 = 32 * nb;
#pragma unroll 8
    for (int i = 0; i < 32; ++i) { const int kk = 2 * i + (lane >> 5); scr[kk * 33 + (lane & 31)] = W[(size_t)(k0 + kk) * N + n0 + (lane & 31)] * (gain ? gain[k0 + kk] : 1.f); }
    LDS_WAIT(); asm volatile("" ::: "memory");
    const int c = lane & 7;
#pragma unroll
    for (int j = 0; j < 4; ++j) { const int n = (lane >> 3) + 8 * j; const LAS float* s = scr + (8 * c) * 33 + n;
        u32x4 o; o.x = pk2(s[0 * 33], s[1 * 33]); o.y = pk2(s[2 * 33], s[3 * 33]); o.z = pk2(s[4 * 33], s[5 * 33]); o.w = pk2(s[6 * 33], s[7 * 33]);
        *(u32x4*)(WT + (size_t)((n0 + n) * rmul + radd) * K + k0 + 8 * c) = o; }
    LDS_WAIT(); asm volatile("" ::: "memory");
}
__device__ __forceinline__ void phase_prologue(CArgs& a, LAS unsigned char* lds, int G) {
    int tid_ = threadIdx.x; asm volatile("" : "+v"(tid_)); const int lane = tid_ & 63, wave = __builtin_amdgcn_readfirstlane(tid_ >> 6), gw = blockIdx.x * 8 + wave, NGW = G * 8;
    unsigned char* ws = a.ws;
    LAS float* scr = (LAS float*)(lds + wave * 16384);
    constexpr int I_QKV = 16 * 96, I_DO = 16 * 32, I_G = 16 * 88, I_DN = 44 * 32;
    constexpr int NITEMS = I_QKV + I_DO + 4 * I_G + 2 * I_DN;
    for (int it = gw; it < NITEMS; it += NGW) {
        int r = it;
        if (r < I_QKV) { p0_transpose_item(a.in[6], DM, 3 * DM, (bf16_t*)(ws + WS_WQKV), 1, 0, scr, r, lane, a.in[1] + DM); continue; } r -= I_QKV;
        if (r < I_DO) { p0_transpose_item(a.in[12], DM, DM, (bf16_t*)(ws + WS_WDO), 1, 0, scr, r, lane, nullptr); continue; } r -= I_DO;
        if (r < 4 * I_G) { const int which = r / I_G, l = which >> 1, up = which & 1; r -= which * I_G;
            p0_transpose_item((up ? a.in[14] : a.in[13]) + (size_t)l * DM * DFF, DM, DFF, (bf16_t*)(ws + (l ? WS_WGU1 : WS_WGU0)), 2, up, scr, r, lane, a.in[3] + l * DM); continue; } r -= 4 * I_G;
        { const int l = r / I_DN; r -= l * I_DN; p0_transpose_item(a.in[15] + (size_t)l * DFF * DM, DFF, DM, (bf16_t*)(ws + (l ? WS_WDN1 : WS_WDN0)), 1, 0, scr, r, lane, nullptr); }
    }
    {
        LAS float* tabc = scr; LAS float* tabs = scr + 128;
        tabc[lane] = cospif((float)lane * (1.f / 64.f)); tabc[lane + 64] = cospif((float)(lane + 64) * (1.f / 64.f));
        tabs[lane] = sinpif((float)lane * (1.f / 64.f)); tabs[lane + 64] = sinpif((float)(lane + 64) * (1.f / 64.f));
        LDS_WAIT(); asm volatile("" ::: "memory");
        const float* wo = a.in[5]; bf16_t* wf = (bf16_t*)(ws + WS_WF);
        for (int it = gw; it < 2048; it += NGW) {
            const int g = it >> 8, nc = (it >> 4) & 15, cc = it & 15;
            float ac[8], as[8];
#pragma unroll
            for (int i = 0; i < 8; ++i) { ac[i] = 0.f; as[i] = 0.f; }
            for (int l = 0; l < 128; ++l) {
                const float w = wo[(size_t)(g * 128 + l) * DM + nc * 64 + lane];
#pragma unroll
                for (int i = 0; i < 8; ++i) { const int idx = (l * (cc * 8 + i)) & 127; ac[i] += tabc[idx] * w; as[i] += tabs[idx] * w; }
            }
            const float s = 0.08838834764831845f;
            u32x4 oc, os;
            oc.x = pk2(ac[0] * s, ac[1] * s); oc.y = pk2(ac[2] * s, ac[3] * s); oc.z = pk2(ac[4] * s, ac[5] * s); oc.w = pk2(ac[6] * s, ac[7] * s);
            os.x = pk2(as[0] * s, as[1] * s); os.y = pk2(as[2] * s, as[3] * s); os.z = pk2(as[4] * s, as[5] * s); os.w = pk2(as[6] * s, as[7] * s);
            bf16_t* dst = wf + (size_t)(nc * 64 + lane) * 1024 + g * 128 + cc * 8;
            *(u32x4*)dst = oc; *(u32x4*)(dst + (size_t)1024 * 1024) = os;
        }
    }
    {
        const int gt = gw * 64 + lane, NT = NGW * 64;
        bf16_t* F1 = (bf16_t*)(ws + WS_F1); bf16_t* F2 = (bf16_t*)(ws + WS_F2); float* TW = (float*)(ws + WS_TW);
        for (int idx = gt; idx < 128 * 64; idx = idx_next(idx, NT)) {
            const int mg = idx >> 6, n1 = idx & 63, s = mg >> 5, ri = (mg >> 4) & 1, kk = mg & 15, k1 = 16 * s + kk, ang = (k1 * n1) & 63;
            const float v = ri ? -sinpif((float)ang * (1.f / 32.f)) : cospif((float)ang * (1.f / 32.f));
            F1[idx] = (bf16_t)f2bf(v);
        }
        for (int idx = gt; idx < 256 * 256; idx = idx_next(idx, NT)) {
            const int m = idx >> 8, K = idx & 255, ri = m >> 7, k2 = m & 127, rip = K >> 7, n2 = K & 127, ang = (k2 * n2) & 127;
            const float c = cospif((float)ang * (1.f / 64.f)), s = sinpif((float)ang * (1.f / 64.f));
            const float v = (ri == rip) ? c : (ri == 0 ? s : -s);
            F2[idx] = (bf16_t)f2bf(v);
        }
        for (int idx = gt; idx < 64 * 128; idx = idx_next(idx, NT)) {
            const int k1 = idx >> 7, n2 = idx & 127, ang = k1 * n2;
            TW[2 * idx] = cospif((float)ang * (1.f / 4096.f)) * 0.125f; TW[2 * idx + 1] = sinpif((float)ang * (1.f / 4096.f)) * 0.125f;
        }
    }
}

__device__ __forceinline__ void phase_fft1(CArgs& a, LAS unsigned char* lds, int G) {
    int tid_ = threadIdx.x; asm volatile("" : "+v"(tid_)); const int tid = tid_, lane = tid & 63, wave = __builtin_amdgcn_readfirstlane(tid >> 6), r = lane & 31, h = lane >> 5, g16 = lane >> 4, q4 = (lane & 15) >> 2, p4 = lane & 3;
    const int s = wave >> 1, ch = wave & 1;
    constexpr int RS = 2048;
    const float* x = a.in[0]; const float* gpre = a.in[1];
    const bf16_t* F1 = (const bf16_t*)(a.ws + WS_F1); const float* TW = (const float*)(a.ws + WS_TW); bf16_t* U = (bf16_t*)(a.ws + WS_U);
    bf16x8 af[4];
    { const int ri_ = r >> 4, k1_ = 16 * s + (r & 15);
#pragma unroll
      for (int ks = 0; ks < 4; ++ks)
#pragma unroll
        for (int j = 0; j < 8; ++j) { const int ang = (k1_ * (16 * ks + 8 * h + j)) & 63; const float v = ri_ ? -sinpif((float)ang * (1.f / 32.f)) : cospif((float)ang * (1.f / 32.f)); af[ks][j] = (short)f2bf(v); } }
    f32x4 gv[4];
#pragma unroll
    for (int j = 0; j < 4; ++j) gv[j] = *(const f32x4*)(gpre + 256 * j + 4 * lane);
    for (int u = blockIdx.x; u < NBATCH * 128; u += G) {
        const int b = u >> 7, n2 = u & 127;
        __syncthreads();
#pragma unroll
        for (int half = 0; half < 2; ++half) {
            f32x4 v[4][4];
#pragma unroll
            for (int i = 0; i < 4; ++i) { const int n1 = 8 * wave + 4 * half + i;
#pragma unroll
                for (int j = 0; j < 4; ++j) v[i][j] = __builtin_nontemporal_load((const f32x4*)(x + ((size_t)(b * SEQ + 128 * n1 + n2)) * DM + 256 * j + 4 * lane)); }
#pragma unroll
            for (int i = 0; i < 4; ++i) { const int n1 = 8 * wave + 4 * half + i; float ss = 0.f;
#pragma unroll
                for (int j = 0; j < 4; ++j) ss += (v[i][j].x * v[i][j].x + v[i][j].y * v[i][j].y) + (v[i][j].z * v[i][j].z + v[i][j].w * v[i][j].w);
                const float rn = rsqrtf(wave_sum(ss) * (1.f / DM) + RMS_EPS);
#pragma unroll
                for (int j = 0; j < 4; ++j) { const f32x4 o = v[i][j] * rn * gv[j]; u32x2 w; w.x = pk2(o.x, o.y); w.y = pk2(o.z, o.w); *(LAS u32x2*)(lds + n1 * RS + (((256 * j + 4 * lane) * 2) ^ ((n1 & 3) << 6))) = w; } }
        }
        __syncthreads();
        f32x2 tw[8];
#pragma unroll
        for (int i = 0; i < 8; ++i) { const int k1 = 16 * s + (i & 3) + 8 * (i >> 2) + 4 * h, ang = k1 * n2; tw[i] = (f32x2){cospif((float)ang * (1.f / 4096.f)) * 0.125f, sinpif((float)ang * (1.f / 4096.f)) * 0.125f}; }
        if (s < 3)
#pragma unroll 2
        for (int cbk = 0; cbk < 16; ++cbk) {
            f32x16 acc = {};
#pragma unroll
            for (int ks = 0; ks < 4; ++ks) {
                const LAS unsigned char* base = lds + (16 * ks + 8 * h + q4) * RS + (((ch * 512 + cbk * 32 + (g16 & 1) * 16 + 4 * p4) * 2) ^ (q4 << 6));
                const s16x4 lo = tr16(base), hi = tr16(base + 4 * RS);
                acc = __builtin_amdgcn_mfma_f32_32x32x16_bf16(af[ks], cat8(lo, hi), acc, 0, 0, 0);
            }
            const int c = ch * 512 + cbk * 32 + r;
#pragma unroll
            for (int i = 0; i < 8; ++i) { const int k1 = 16 * s + (i & 3) + 8 * (i >> 2) + 4 * h;
                const float tre = acc[i], tim = acc[i + 8];
                const float ure = tre * tw[i].x + tim * tw[i].y, uim = tim * tw[i].x - tre * tw[i].y;
                bf16_t* dst = U + (((size_t)(b * 64 + k1) * 2) * 128 + n2) * DM + c;
                if (k1 <= 32) { dst[0] = (bf16_t)f2bf(ure); dst[(size_t)128 * DM] = (bf16_t)f2bf(uim); } }
        }
    }
}

__device__ __forceinline__ void phase_fft2(CArgs& a, LAS unsigned char* lds, int G) {
    int tid_ = threadIdx.x; asm volatile("" : "+v"(tid_)); const int tid = tid_, lane = tid & 63, wave = __builtin_amdgcn_readfirstlane(tid >> 6), r = lane & 31, h = lane >> 5, g16 = lane >> 4, q4 = (lane & 15) >> 2, p4 = lane & 3;
    constexpr int RS = 272;
    const bf16_t* U = (const bf16_t*)(a.ws + WS_U); const bf16_t* F2 = (const bf16_t*)(a.ws + WS_F2); bf16_t* A = (bf16_t*)(a.ws + WS_A);
    for (int u = blockIdx.x; u < NB_F2; u += G) {
        const int b = u / 264, k1 = (u % 264) >> 3, cb = u & 7;
        __syncthreads();
#pragma unroll
        for (int pass = 0; pass < 8; ++pass) { const int row = pass * 32 + (tid >> 4), c16 = tid & 15;
            const u32x4 v = *(const u32x4*)(U + ((size_t)(b * 64 + k1) * 256 + row) * DM + cb * 128 + c16 * 8);
            *(LAS u32x4*)(lds + row * RS + c16 * 16) = v; }
        __syncthreads();
        f32x16 acc[4];
#pragma unroll
        for (int i = 0; i < 4; ++i) acc[i] = (f32x16){};
#pragma unroll 4
        for (int ks = 0; ks < 16; ++ks) {
            const bf16x8 af = *(const bf16x8*)(F2 + (wave * 32 + r) * 256 + 16 * ks + 8 * h);
#pragma unroll
            for (int cbk = 0; cbk < 4; ++cbk) {
                const LAS unsigned char* base = lds + (16 * ks + 8 * h + q4) * RS + (cbk * 32 + (g16 & 1) * 16 + 4 * p4) * 2;
                const s16x4 lo = tr16(base), hi = tr16(base + 4 * RS);
                acc[cbk] = __builtin_amdgcn_mfma_f32_32x32x16_bf16(af, cat8(lo, hi), acc[cbk], 0, 0, 0);
            }
        }
        const int ri = wave >> 2;
#pragma unroll
        for (int cbk = 0; cbk < 4; ++cbk)
#pragma unroll
            for (int reg = 0; reg < 16; ++reg) { const int k2 = 32 * (wave & 3) + (reg & 3) + 8 * (reg >> 2) + 4 * h; const size_t arow = (size_t)ri * MH + (size_t)(b * 33 + k1) * 128 + k2;
                A[arow * 1024 + cb * 128 + cbk * 32 + r] = (bf16_t)f2bf(acc[cbk][reg] * 0.08838834764831845f); }
    }
}

constexpr int EWR = 4;
template <bool IN_BF16, bool OUT_F32>
__device__ __forceinline__ void phase_ew(const void* hin_, const bf16_t* mb, const float* ssq, const float* gpost, const float* gnext, void* hout_, bf16_t* xn, int G) {
    int tid_ = threadIdx.x; asm volatile("" : "+v"(tid_)); const int lane = tid_ & 63, wave = __builtin_amdgcn_readfirstlane(tid_ >> 6), gw = blockIdx.x * 8 + wave, NGW = G * 8;
    f32x4 gp[4];
#pragma unroll
    for (int j = 0; j < 4; ++j) gp[j] = *(const f32x4*)(gpost + 256 * j + 4 * lane);
    typedef f32x4 hraw_t;
#define EW_LOAD(HV_, MW_, SP_, m0_) do { _Pragma("unroll") for (int i = 0; i < EWR; ++i) { SP_[i] = ssq[(size_t)((m0_) + i) * 16 + (lane & 15)]; \
        _Pragma("unroll") for (int j = 0; j < 4; ++j) { const size_t off = (size_t)((m0_) + i) * DM + 256 * j + 4 * lane; \
            HV_[i][j] = __builtin_nontemporal_load((const u32x2*)((const bf16_t*)hin_ + off)); \
            MW_[i][j] = __builtin_nontemporal_load((const u32x2*)(mb + off)); } } } while (0)
#define EW_PROC(HV_, MW_, SP_, m0_) do { _Pragma("unroll") for (int i = 0; i < EWR; ++i) { \
        float t = SP_[i]; t = row16_sum(t); \
        const float rstd = rsqrtf(t * (1.f / DM) + RMS_EPS); float ss = 0.f; \
        _Pragma("unroll") for (int j = 0; j < 4; ++j) { const size_t off = (size_t)((m0_) + i) * DM + 256 * j + 4 * lane; \
            const f32x4 mf = (f32x4){bf_lo(MW_[i][j].x), bf_hi(MW_[i][j].x), bf_lo(MW_[i][j].y), bf_hi(MW_[i][j].y)}; \
            const f32x4 hf = (f32x4){bf_lo(HV_[i][j].x), bf_hi(HV_[i][j].x), bf_lo(HV_[i][j].y), bf_hi(HV_[i][j].y)}; const f32x4 v = hf + mf * rstd * gp[j]; \
            if (OUT_F32) __builtin_nontemporal_store(v, (f32x4*)((float*)hout_ + off)); \
            else { u32x2 w; w.x = pk2(v.x, v.y); w.y = pk2(v.z, v.w); *(u32x2*)((bf16_t*)hout_ + off) = w; } \
            ss += (v.x * v.x + v.y * v.y) + (v.z * v.z + v.w * v.w); } \
        if (gnext) { const float r2 = rsqrtf(wave_sum(ss) * (1.f / DM) + RMS_EPS); if (lane == 0) ((float*)xn)[(m0_) + i] = r2; } } } while (0)
    const int step = NGW * EWR;
    static_assert(IN_BF16, "the f32-input residual pass is the Fourier one");
    u32x2 hvA[EWR][4], hvB[EWR][4], mwA[EWR][4], mwB[EWR][4]; float spA[EWR], spB[EWR];
    int m0 = gw * EWR;
    if (m0 < MTOK) EW_LOAD(hvA, mwA, spA, m0);
    while (m0 < MTOK) {
        const int m1 = m0 + step;
        if (m1 < MTOK) EW_LOAD(hvB, mwB, spB, m1);
        EW_PROC(hvA, mwA, spA, m0);
        if (m1 >= MTOK) break;
        m0 = m1 + step;
        if (m0 < MTOK) EW_LOAD(hvA, mwA, spA, m0);
        EW_PROC(hvB, mwB, spB, m1);
    }
#undef EW_LOAD
#undef EW_PROC
}

__device__ __forceinline__ void phase_ew_fourier(const float* x, const bf16_t* pq, const float* gpost, const float* gnext, bf16_t* hb, bf16_t* xn, int G) {
    int tid_ = threadIdx.x; asm volatile("" : "+v"(tid_)); const int lane = tid_ & 63, wave = __builtin_amdgcn_readfirstlane(tid_ >> 6), gw = blockIdx.x * 8 + wave, NGW = G * 8;
    f32x4 gp[4], gn[4];
#pragma unroll
    for (int j = 0; j < 4; ++j) { gp[j] = *(const f32x4*)(gpost + 256 * j + 4 * lane); gn[j] = *(const f32x4*)(gnext + 256 * j + 4 * lane); }
    for (int m0 = gw * EWR; m0 < MTOK; m0 += NGW * EWR) {
        f32x4 hv[EWR][4]; u32x2 pw[EWR][4], qw[EWR][4]; float sg[EWR];
#pragma unroll
        for (int i = 0; i < EWR; ++i) { const int m = m0 + i, b = m >> 13, k = m & 8191, k1 = k & 63, k2 = k >> 6;
            const bool dir = (k1 <= 32); const size_t src = dir ? (size_t)(b * 33 + k1) * 128 + k2 : (size_t)(b * 33 + (64 - k1)) * 128 + (127 - k2);
            sg[i] = dir ? 1.f : -1.f;
#pragma unroll
            for (int j = 0; j < 4; ++j) { const int co = 256 * j + 4 * lane;
                hv[i][j] = __builtin_nontemporal_load((const f32x4*)(x + (size_t)m * DM + co));
                pw[i][j] = *(const u32x2*)(pq + src * DM + co); qw[i][j] = *(const u32x2*)(pq + ((size_t)MH + src) * DM + co); } }
#pragma unroll
        for (int i = 0; i < EWR; ++i) {
            f32x4 mv[4]; float s1 = 0.f;
#pragma unroll
            for (int j = 0; j < 4; ++j) { const f32x4 pf = (f32x4){bf_lo(pw[i][j].x), bf_hi(pw[i][j].x), bf_lo(pw[i][j].y), bf_hi(pw[i][j].y)}, qf = (f32x4){bf_lo(qw[i][j].x), bf_hi(qw[i][j].x), bf_lo(qw[i][j].y), bf_hi(qw[i][j].y)};
                mv[j] = pf + qf * sg[i]; s1 += (mv[j].x * mv[j].x + mv[j].y * mv[j].y) + (mv[j].z * mv[j].z + mv[j].w * mv[j].w); }
            const float rstd = rsqrtf(wave_sum(s1) * (1.f / DM) + RMS_EPS);
            float ss = 0.f;
#pragma unroll
            for (int j = 0; j < 4; ++j) { const size_t off = (size_t)(m0 + i) * DM + 256 * j + 4 * lane;
                const f32x4 v = hv[i][j] + mv[j] * rstd * gp[j]; hv[i][j] = v;
                u32x2 w; w.x = pk2(v.x, v.y); w.y = pk2(v.z, v.w); __builtin_nontemporal_store(w, (u32x2*)(hb + off));
                ss += (v.x * v.x + v.y * v.y) + (v.z * v.z + v.w * v.w); }
            const float r2 = rsqrtf(wave_sum(ss) * (1.f / DM) + RMS_EPS);
            if (lane == 0) ((float*)xn)[m0 + i] = r2;
        }
    }
}
__device__ __forceinline__ void phase_knorm(CArgs& a, int G) {
    int tid_ = threadIdx.x; asm volatile("" : "+v"(tid_)); const int lane = tid_ & 63, wave = __builtin_amdgcn_readfirstlane(tid_ >> 6), gw = blockIdx.x * 8 + wave, NGW = G * 8;
    const bf16_t* K = (const bf16_t*)(a.ws + WS_K); unsigned* kmax2 = (unsigned*)(a.ws + WS_CTL);
    for (int ch = gw; ch < MTOK / 32; ch += NGW) {
        float mx = 0.f;
        for (int i = 0; i < 32; ++i) {
            const bf16_t* p = K + (size_t)(ch * 32 + i) * DM + 16 * lane;
            const u32x4 v0 = *(const u32x4*)p, v1 = *(const u32x4*)(p + 8);
            float s = 0.f;
#pragma unroll
            for (int e = 0; e < 4; ++e) { const float a0 = bf_lo(v0[e]), a1 = bf_hi(v0[e]), b0 = bf_lo(v1[e]), b1 = bf_hi(v1[e]); s += (a0 * a0 + a1 * a1) + (b0 * b0 + b1 * b1); }
            s += __shfl_xor(s, 1); s += __shfl_xor(s, 2);
            mx = __builtin_fmaxf(mx, s);
        }
        if ((lane & 3) == 0) atomicMax(kmax2 + (ch >> 8) * 16 + (lane >> 2), __builtin_bit_cast(unsigned, mx));
    }
}

__device__ __forceinline__ void glds16(const void* gsrc, unsigned lds_dst) { unsigned keep;
    asm volatile("s_mov_b32 %0, m0\n\ts_mov_b32 m0, %2\n\ts_nop 0\n\tglobal_load_lds_dwordx4 %1, off\n\ts_mov_b32 m0, %0" : "=&s"(keep) : "v"(gsrc), "s"(lds_dst) : "memory"); }
__device__ __forceinline__ void phase_attn(CArgs& a, LAS unsigned char* lds, int G, int rep) {
    int tid_ = threadIdx.x; asm volatile("" : "+v"(tid_)); const int tid = tid_, lane = tid & 63, wave = __builtin_amdgcn_readfirstlane(tid >> 6), r = lane & 31, h = lane >> 5, g16 = lane >> 4, q4 = (lane & 15) >> 2, p4 = lane & 3;
    const int comp = wave >> 2, qs = wave & 3;
    const bf16_t* Q = (const bf16_t*)(a.ws + WS_Q); const bf16_t* K = (const bf16_t*)(a.ws + WS_K); const bf16_t* V = (const bf16_t*)(a.ws + WS_V); bf16_t* O = (bf16_t*)(a.ws + WS_O);
    unsigned* ctl = (unsigned*)(a.ws + WS_CTL);
    float s1 = 0.f, s2 = 0.f;
    for (int i = 0; i < 64; ++i) { s1 += a.in[7][i] * a.in[8][i]; s2 += a.in[9][i] * a.in[10][i]; }
    const float lam_init = 0.8f - 0.6f * 0.74081822068171786607f;
    const float lam = expf(s1) - expf(s2) + lam_init;
    const float* subg = a.in[11];
    constexpr int NKT = SEQ / 64, CTL_OFF = 131072, SLOT = 32768, NSLOT = 4;
    const unsigned lds0 = (unsigned)(uintptr_t)lds;
    const int krow = 8 * wave + (lane >> 3), kc = (lane & 7) ^ ((krow >> 1) & 7);
    const int vrow = 4 * wave + (lane >> 4), vc = (lane & 15) ^ ((vrow & 3) << 2);
    const int goK = krow * DM + kc * 8, goV = vrow * DM + vc * 8;
    int kofs[4], vofs[4];
#pragma unroll
    for (int i = 0; i < 4; ++i) { kofs[i] = r * 128 + (((2 * i + h) ^ ((r >> 1) & 7)) * 16); vofs[i] = (4 * h + q4) * 256 + ((i ^ q4) * 64) + (g16 & 1) * 32 + p4 * 8; }
    volatile LAS unsigned* lctl = (volatile LAS unsigned*)(lds + CTL_OFF);
    for (int qi = 0; qi < 8; ++qi) {
        const int xq = (blockIdx.x + qi) & 7;
        __syncthreads();
        if (tid == 0) lctl[0] = atomicAdd(ctl + 128 + 8 * rep + xq, 1u);
        for (;;) {
            __syncthreads();
            const int idx = (int)lctl[0];
            if (idx >= 512) break;
            unsigned nidx = 0u; if (tid == 0) nidx = atomicAdd(ctl + 128 + 8 * rep + xq, 1u);
            const int hh = 7 - (idx >> 6), b = (xq + hh) & 7, qblk = idx & 63;
            const float slope2 = exp2f(-(float)(hh + 1)) * 1.4426950408889634f;
            const int q0 = qblk * 128, qw0 = q0 + 32 * qs, qpos = qw0 + r;
            const int R = (int)(135.0f / slope2) + 1;
            int kt_lo = (q0 - 63 - R + 63) >> 6; kt_lo = kt_lo < 0 ? 0 : kt_lo;
            int kt_hi = (q0 + 127 + R) >> 6; kt_hi = kt_hi > NKT - 1 ? NKT - 1 : kt_hi;
            const bf16_t* Kt0 = K + ((size_t)b * SEQ) * DM + hh * 128 + goK;
            const bf16_t* Vt0 = V + ((size_t)b * SEQ) * DM + hh * 128 + goV;
#define AT_ISSUE(kt_, sl_) do { const size_t go_ = (size_t)(kt_) * 64 * DM; const unsigned d_ = (unsigned)__builtin_amdgcn_readfirstlane((int)(lds0 + (unsigned)((sl_) * SLOT + wave * 1024))); \
                glds16(Kt0 + go_, d_); glds16(Kt0 + go_ + 64, d_ + 8192u); glds16(Vt0 + go_, d_ + 16384u); glds16(Vt0 + go_ + (size_t)32 * DM, d_ + 24576u); } while (0)
#define AT_CLAMP(k_) ((k_) <= kt_hi ? (k_) : kt_hi)
            asm volatile("s_waitcnt vmcnt(0)" ::: "memory");
            AT_ISSUE(kt_lo, 0); AT_ISSUE(AT_CLAMP(kt_lo + 1), 1); AT_ISSUE(AT_CLAMP(kt_lo + 2), 2);
            const bf16_t* Qrow = Q + ((size_t)(b * SEQ + qpos)) * DM + hh * 128 + comp * 64;
            bf16x8 qf[4]; float qn = 0.f;
#pragma unroll
            for (int d0 = 0; d0 < 4; ++d0) { qf[d0] = *(const bf16x8*)(Qrow + 16 * d0 + 8 * h);
                const u32x4 w = __builtin_bit_cast(u32x4, qf[d0]);
#pragma unroll
                for (int e = 0; e < 4; ++e) { const float x0 = bf_lo(w[e]), x1 = bf_hi(w[e]); qn += x0 * x0 + x1 * x1; } }
            qn += __shfl_xor(qn, 32);
            const float kmx = __builtin_bit_cast(float, __hip_atomic_load(ctl + 256 + (b * 16 + hh * 2 + comp) * 2, __ATOMIC_RELAXED, __HIP_MEMORY_SCOPE_AGENT))
                            + __builtin_bit_cast(float, __hip_atomic_load(ctl + 256 + (b * 16 + hh * 2 + comp) * 2 + 1, __ATOMIC_RELAXED, __HIP_MEMORY_SCOPE_AGENT));
            const float Bi = sqrtf(qn * kmx) * 1.002f + 0.05f;
            f32x16 ot[4];
#pragma unroll
            for (int i = 0; i < 4; ++i) ot[i] = (f32x16){};
            f32x4 lacc = (f32x4){0.f, 0.f, 0.f, 0.f};
            const short one_ = ((lane & 15) == ((lane >> 4) & 1)) ? (short)0x3F80 : (short)0;
            const bf16x8 onesA = (bf16x8){one_, one_, one_, one_, one_, one_, one_, one_};
#define AT_CINIT(S_, kt_) do { \
                if ((kt_) * 64 + 63 <= qw0) { const float L_ = slope2 * (float)((kt_) * 64 + 4 * h - qpos) - Bi; \
                    _Pragma("unroll") for (int blk = 0; blk < 2; ++blk) _Pragma("unroll") for (int reg = 0; reg < 16; ++reg) S_[blk][reg] = __builtin_fmaf(slope2, (float)((reg & 3) + 8 * (reg >> 2) + 32 * blk), L_); } \
                else if ((kt_) * 64 >= qw0 + 31) { const float L_ = slope2 * (float)(qpos - (kt_) * 64 - 4 * h) - Bi; \
                    _Pragma("unroll") for (int blk = 0; blk < 2; ++blk) _Pragma("unroll") for (int reg = 0; reg < 16; ++reg) S_[blk][reg] = __builtin_fmaf(-slope2, (float)((reg & 3) + 8 * (reg >> 2) + 32 * blk), L_); } \
                else { const float dq_ = (float)(qpos - (kt_) * 64 - 4 * h); \
                    _Pragma("unroll") for (int blk = 0; blk < 2; ++blk) _Pragma("unroll") for (int reg = 0; reg < 16; ++reg) S_[blk][reg] = -slope2 * __builtin_fabsf(dq_ - (float)((reg & 3) + 8 * (reg >> 2) + 32 * blk)) - Bi; } } while (0)
            f32x16 sa[2];
            AT_CINIT(sa, kt_lo);
            asm volatile("s_waitcnt vmcnt(8)" ::: "memory"); __builtin_amdgcn_s_barrier(); asm volatile("" ::: "memory");
#define SB() __builtin_amdgcn_sched_barrier(0)
#define AT_SMQ(PW_, SRC_, b_, d_) do { ee_[2 * (d_)] = __builtin_amdgcn_exp2f(SRC_[(b_) + 2 * (d_)]); ee_[2 * (d_) + 1] = __builtin_amdgcn_exp2f(SRC_[(b_) + 2 * (d_) + 1]); \
                if ((d_) >= 1) PW_[(d_) - 1] = pk2(ee_[2 * (d_) - 2], ee_[2 * (d_) - 1]); if ((d_) == 3) PW_[3] = pk2(ee_[6], ee_[7]); } while (0)
#define AT_PV_STAGE(KS_, VLO_, VHI_, PWC_, NLO_, NHI_, FILL_) do { const bf16x8 pf_ = __builtin_bit_cast(bf16x8, PWC_); float ee_[8]; \
                lacc = __builtin_amdgcn_mfma_f32_16x16x32_bf16(onesA, pf_, lacc, 0, 0, 0); SB(); \
                _Pragma("unroll") for (int dvb = 0; dvb < 4; ++dvb) { \
                    ot[dvb] = __builtin_amdgcn_mfma_f32_32x32x16_bf16(cat8(VLO_[dvb], VHI_[dvb]), pf_, ot[dvb], 0, 0, 0); SB(); \
                    FILL_(dvb); \
                    if ((KS_) < 3) { NLO_[dvb] = tr16(vbase + vofs[dvb] + 4096 * ((KS_) + 1)); NHI_[dvb] = tr16(vbase + vofs[dvb] + 4096 * ((KS_) + 1) + 2048); } SB(); } } while (0)
            for (int kt = kt_lo; kt <= kt_hi; ++kt) {
                const int it = kt - kt_lo, sl = it & 3;
                const int ktn = AT_CLAMP(kt + 1);
                const bool leftn = (ktn * 64 + 63 <= qw0), rightn = (ktn * 64 >= qw0 + 31);
                const float sg = leftn ? slope2 : -slope2;
                const float LL = (leftn ? slope2 * (float)(ktn * 64 + 4 * h - qpos) : slope2 * (float)(qpos - ktn * 64 - 4 * h)) - Bi;
                AT_ISSUE(AT_CLAMP(kt + 3), (it + 3) & 3);
                const LAS unsigned char* kbase = lds + sl * SLOT + comp * 8192;
                const LAS unsigned char* vbase = lds + sl * SLOT + 16384;
                bf16x8 kf[8];
#pragma unroll
                for (int i = 0; i < 8; ++i) kf[i] = *(const LAS bf16x8*)(kbase + kofs[i & 3] + 4096 * (i >> 2));
                SB();
                s16x4 vlo[4], vhi[4], nlo[4], nhi[4];
                u32x4 pwa, pwb;
#pragma unroll
                for (int i = 0; i < 4; ++i) { sa[0] = __builtin_amdgcn_mfma_f32_32x32x16_bf16(kf[i], qf[i], sa[0], 0, 0, 0); SB();
                    vlo[i] = tr16(vbase + vofs[i]); vhi[i] = tr16(vbase + vofs[i] + 2048); SB(); }
                { float ee_[8];
#pragma unroll
                for (int i = 0; i < 4; ++i) { sa[1] = __builtin_amdgcn_mfma_f32_32x32x16_bf16(kf[4 + i], qf[i], sa[1], 0, 0, 0); SB();
                    AT_SMQ(pwa, sa[0], 0, i); SB(); } }
#define AT_FILL1(d_) AT_SMQ(pwb, sa[0], 8, d_)
#define AT_FILL2(d_) AT_SMQ(pwa, sa[1], 0, d_)
#define AT_FILL3(d_) AT_SMQ(pwb, sa[1], 8, d_)
                AT_PV_STAGE(0, vlo, vhi, pwa, nlo, nhi, AT_FILL1);
                AT_PV_STAGE(1, nlo, nhi, pwb, vlo, vhi, AT_FILL2);
                AT_PV_STAGE(2, vlo, vhi, pwa, nlo, nhi, AT_FILL3);
#define AT_FILL4(d_) do { _Pragma("unroll") for (int q_ = 0; q_ < 8; ++q_) { const int idx_ = 8 * (d_) + q_, blk_ = idx_ >> 4, reg_ = idx_ & 15; \
                    sa[blk_][reg_] = __builtin_fmaf(sg, (float)((reg_ & 3) + 8 * (reg_ >> 2) + 32 * blk_), LL); } asm volatile("" : "+v"(sa[(d_) >> 1])); } while (0)
                AT_PV_STAGE(3, nlo, nhi, pwb, vlo, vhi, AT_FILL4);
#undef AT_FILL1
#undef AT_FILL2
#undef AT_FILL3
#undef AT_FILL4
                if (!(leftn || rightn)) {
                    const float dq_ = (float)(qpos - ktn * 64 - 4 * h);
#pragma unroll
                    for (int blk = 0; blk < 2; ++blk)
#pragma unroll
                        for (int reg = 0; reg < 16; ++reg) sa[blk][reg] = -slope2 * __builtin_fabsf(dq_ - (float)((reg & 3) + 8 * (reg >> 2) + 32 * blk)) - Bi; }
                asm volatile("s_waitcnt vmcnt(8) lgkmcnt(0)" ::: "memory"); __builtin_amdgcn_s_barrier(); asm volatile("" ::: "memory");
            }
            asm volatile("s_waitcnt vmcnt(0)" ::: "memory"); __builtin_amdgcn_s_barrier(); asm volatile("" ::: "memory");
#undef AT_ISSUE
#undef AT_CLAMP
#undef SB
#undef AT_SMQ
#undef AT_PV_STAGE
#undef AT_CINIT
            const float la_ = __shfl(lacc[0], lane & 15), lb_ = __shfl(lacc[1], lane & 15);
            const float ltot = (r & 16) ? lb_ : la_;
            LAS float* X = (LAS float*)lds;
            if (comp == 1) { const float sc = lam / ltot;
#pragma unroll
                for (int dvb = 0; dvb < 4; ++dvb)
#pragma unroll
                    for (int reg = 0; reg < 16; ++reg) X[(qs * 64 + dvb * 16 + reg) * 64 + lane] = ot[dvb][reg] * sc; }
            __syncthreads();
            if (comp == 0) { const float inv = 1.f / ltot; float ss = 0.f;
#pragma unroll
                for (int dvb = 0; dvb < 4; ++dvb)
#pragma unroll
                    for (int reg = 0; reg < 16; ++reg) { const float o = ot[dvb][reg] * inv - X[(qs * 64 + dvb * 16 + reg) * 64 + lane]; ot[dvb][reg] = o; ss += o * o; }
                ss += __shfl_xor(ss, 32);
                const float rs = rsqrtf(ss * (1.f / 128.f) + RMS_EPS) * (1.f - lam_init);
                bf16_t* Orow = O + ((size_t)(b * SEQ + qpos)) * DM + hh * 128;
#pragma unroll
                for (int dvb = 0; dvb < 4; ++dvb)
#pragma unroll
                    for (int aa = 0; aa < 4; ++aa) { const int dv0 = 32 * dvb + 8 * aa + 4 * h; const f32x4 g4 = *(const f32x4*)(subg + dv0);
                        u32x2 w; w.x = pk2(ot[dvb][4 * aa + 0] * rs * g4.x, ot[dvb][4 * aa + 1] * rs * g4.y); w.y = pk2(ot[dvb][4 * aa + 2] * rs * g4.z, ot[dvb][4 * aa + 3] * rs * g4.w);
                        *(u32x2*)(Orow + dv0) = w; } }
            __syncthreads();
            if (tid == 0) lctl[0] = nidx;
        }
    }
}

#define XB_TMO      128
#define XB_XCNT(j)  (256  + 64 * (j))
#define XB_XSUB(j)  (1280 + 64 * (j))
#define XB_XGEN(j)  (2304 + 64 * (j))
#define XB_TOP      3328
#define XB_TOPGEN   3392
#define XCD_BAR_WORDS 3456
#define XB_SPIN_CAP (1u << 18)

__device__ __forceinline__ unsigned xb_ld(unsigned* p)              { return __hip_atomic_load(p, __ATOMIC_RELAXED, __HIP_MEMORY_SCOPE_AGENT); }
__device__ __forceinline__ unsigned xb_add(unsigned* p, unsigned v) { return __hip_atomic_fetch_add(p, v, __ATOMIC_RELAXED, __HIP_MEMORY_SCOPE_AGENT); }
__device__ __forceinline__ unsigned xb_xcc_id() { return (unsigned)__builtin_amdgcn_s_getreg((3 << 11) | 20) & 0xFu; }
#define XB_SPIN(cond, bar) do { unsigned _sp = 0; while (cond) { __builtin_amdgcn_s_sleep(1); \
    if ((++_sp & 255u) == 0u) { if (xb_ld(&(bar)[XB_TMO])) break; if (_sp > XB_SPIN_CAP) { atomicAdd(&(bar)[XB_TMO], 1u); break; } } } } while (0)

struct XcdBarrier {
    unsigned* bar; unsigned x;
    volatile LAS unsigned* st;
};

__device__ __forceinline__ XcdBarrier xcd_barrier_post(unsigned* bar, volatile LAS unsigned* st) {
    XcdBarrier b; b.bar = bar; b.x = xb_xcc_id(); b.st = st;
    if (threadIdx.x == 0) (void)xb_add(&bar[XB_XCNT(b.x)], 1u);
    return b;
}
__device__ __forceinline__ void xcd_barrier_complete(unsigned* bar, unsigned x, unsigned& nloc, unsigned& nx) {
    const unsigned G = gridDim.x * gridDim.y * gridDim.z;
    unsigned sum, cnt, mine, sp = 0u;
    for (;;) {
        sum = 0u; cnt = 0u; mine = 0u;
#pragma unroll
        for (unsigned j = 0; j < 16; ++j) { const unsigned c = xb_ld(&bar[XB_XCNT(j)]); sum += c; cnt += (c > 0u) ? 1u : 0u; mine = (j == x) ? c : mine; }
        if (sum == G) break;
        __builtin_amdgcn_s_sleep(1);
        if ((++sp & 255u) == 0u) { if (xb_ld(&bar[XB_TMO])) break; if (sp > XB_SPIN_CAP) { atomicAdd(&bar[XB_TMO], 1u); break; } }
    }
    nloc = mine > 0u ? mine : 1u; nx = cnt > 0u ? cnt : 1u;
}

__device__ __forceinline__ void xcd_barrier(const XcdBarrier& b) {
    asm volatile("s_waitcnt vmcnt(0)" ::: "memory");
    __syncthreads();
    if (threadIdx.x == 0) {
        unsigned* bar = b.bar;
        __builtin_amdgcn_s_waitcnt(0);
        unsigned nloc = b.st[0], nx = b.st[1];
        if (nloc == 0u) { xcd_barrier_complete(bar, b.x, nloc, nx); b.st[0] = nloc; b.st[1] = nx; }
        const unsigned old = xb_add(&bar[XB_XSUB(b.x)], 1u);
        const unsigned gen = old / nloc;
        if (old + 1u == (gen + 1u) * nloc) {
            __builtin_amdgcn_fence(__ATOMIC_RELEASE, "agent");
            asm volatile("s_waitcnt vmcnt(0)" ::: "memory");
            const unsigned og = xb_add(&bar[XB_TOP], 1u);
            const unsigned tg = og / nx;
            if (og + 1u == (tg + 1u) * nx) xb_add(&bar[XB_TOPGEN], 1u);
            else XB_SPIN(xb_ld(&bar[XB_TOPGEN]) == tg, bar);
            __builtin_amdgcn_fence(__ATOMIC_ACQUIRE, "agent");
            xb_add(&bar[XB_XGEN(b.x)], 1u);
            asm volatile("s_waitcnt vmcnt(0)" ::: "memory");
        } else {
            XB_SPIN(xb_ld(&bar[XB_XGEN(b.x)]) == gen, bar);
            __builtin_amdgcn_fence(__ATOMIC_ACQUIRE, "agent");
            asm volatile("s_waitcnt vmcnt(0)" ::: "memory");
        }
    }
    __syncthreads();
}

__global__ void __launch_bounds__(512, 2) mega_fwd(Args a_) {
    extern __shared__ __attribute__((aligned(16))) unsigned char lds_raw[];
    LAS unsigned char* lds = (LAS unsigned char*)lds_raw;
    cg::grid_group grid = cg::this_grid();
    if (threadIdx.x < 64) ((LAS unsigned*)(lds + 131072))[threadIdx.x] = 0u;
    __syncthreads();
    (void)xcd_barrier_post((unsigned*)(a_.ws + WS_CTL) + 4096, (volatile LAS unsigned*)(lds + 131072 + 64));
        const int G = gridDim.x;
#ifndef PROBE_MASK
#define PROBE_MASK 0
#endif
    for (int ph = a_.ph_lo; ph < a_.ph_hi; ++ph) {
      CArgs* ap = (CArgs*)__builtin_amdgcn_kernarg_segment_ptr(); asm volatile("" : "+s"(ap)); CArgs& a = *ap;
      unsigned char* ws = a.ws;
      const int nrep = ((PROBE_MASK >> ph) & 1) ? 2 : 1;
      for (int rep = 0; rep < nrep; ++rep) {
        if (0) {}
#if !defined(PHM) || (PHM & 1)
        else if (ph == 0) { phase_prologue(a, lds, G); phase_fft1(a, lds, G); }
#endif
#if !defined(PHM) || (PHM & 2)
        else if (ph == 1) { }
#endif
#if !defined(PHM) || (PHM & 4)
        else if (ph == 2) phase_fft2(a, lds, G);
#endif
#if !defined(PHM) || (PHM & 8)
        else if (ph == 9) { }
        else if (ph == 10) phase_attn(a, lds, G, rep);
#endif
#if !defined(PHM) || (PHM & 16)
        else if (ph == 3) {
            pg8::Gemm g{(const bf16_t*)(ws + WS_A), (const bf16_t*)(ws + WS_WF), 2 * MH, 2 * DM, DM}; pg8::StackedOrder S{G, (int)blockIdx.x};
            pg8::EpiBf16 E{(bf16_t*)(ws + WS_U), DM, DM, 0, 1.f, nullptr, nullptr};
            pg8::gemm_phase<pg8::EpiBf16, pg8::StackedOrder, true, true>(lds, g, S, E);
        }
        else if (ph == 6 || ph == 11 || ph == 14) {
            const bf16_t* A; const bf16_t* Bt; int K;
            if (ph == 11) { A = (const bf16_t*)(ws + WS_O); Bt = (const bf16_t*)(ws + WS_WDO); K = DM; }
            else { A = (const bf16_t*)(ws + WS_HFF); Bt = (const bf16_t*)(ws + (ph == 6 ? WS_WDN0 : WS_WDN1)); K = DFF; }
            pg8::Gemm g{A, Bt, MTOK, DM, K}; pg8::StaticOrder S; S.init(MTOK, DM, G, (int)blockIdx.x);
            pg8::EpiBf16Ssq E{(bf16_t*)(ws + WS_MB), DM, (float*)(ws + WS_SSQ)};
            pg8::gemm_phase<pg8::EpiBf16Ssq, pg8::StaticOrder, true, true>(lds, g, S, E);
        }
#endif
#if !defined(PHM) || (PHM & 32)
        else if (ph == 5 || ph == 13) {
            pg8::Gemm g{(const bf16_t*)(ws + WS_HB), (const bf16_t*)(ws + (ph == 5 ? WS_WGU0 : WS_WGU1)), MTOK, 2 * DFF, DM}; pg8::StaticOrder S; S.init(MTOK, 2 * DFF, G, (int)blockIdx.x);
            pg8::EpiSwiglu E{(bf16_t*)(ws + WS_HFF), DFF, (const float*)(ws + WS_RSB)};
            pg8::gemm_phase<pg8::EpiSwiglu, pg8::StaticOrder, true, true>(lds, g, S, E);
        }
#endif
#if !defined(PHM) || (PHM & 64)
        else if (ph == 8) {
            pg8::Gemm g{(const bf16_t*)(ws + WS_HB), (const bf16_t*)(ws + WS_WQKV), MTOK, 3 * DM, DM}; pg8::StaticOrder S; S.init(MTOK, 3 * DM, G, (int)blockIdx.x);
            pg8::EpiBf16 E{(bf16_t*)(ws + WS_Q), DM, DM, (size_t)(WS_K - WS_Q) / 2, 0.125f * 1.4426950408889634f, (const float*)(ws + WS_RSB), (unsigned*)(ws + WS_CTL) + 256};
            pg8::gemm_phase<pg8::EpiBf16, pg8::StaticOrder, true, true>(lds, g, S, E);
        }
#endif
        else {
            const int l = (ph >= 12) ? 1 : 0; const bool mix = (ph == 4 || ph == 12);
            const float* gpost = (mix ? a.in[2] : a.in[4]) + l * DM;
            const float* gnext = (ph == 15) ? nullptr : (ph == 7 ? a.in[1] + DM : a.in[3] + l * DM);
            bf16_t* hb = (bf16_t*)(ws + WS_HB);
            if (ph == 4) phase_ew_fourier(a.in[0], (const bf16_t*)(ws + WS_U), gpost, gnext, hb, (bf16_t*)(ws + WS_RSB), G);
            else if (ph == 15) phase_ew<true, true>(hb, (const bf16_t*)(ws + WS_MB), (const float*)(ws + WS_SSQ), gpost, gnext, a.out, (bf16_t*)(ws + WS_RSB), G);
            else phase_ew<true, false>(hb, (const bf16_t*)(ws + WS_MB), (const float*)(ws + WS_SSQ), gpost, gnext, hb, (bf16_t*)(ws + WS_RSB), G);
        }
      }
        if (ph + 1 < a_.ph_hi && ph != 9 && ph != 0) { if (ph == 1000) grid.sync(); else { XcdBarrier b_; b_.bar = (unsigned*)(a.ws + WS_CTL) + 4096; b_.x = xb_xcc_id(); b_.st = (volatile LAS unsigned*)(lds + 131072 + 64); xcd_barrier(b_); } }
    }
}

#ifndef MK_ONE_LAUNCH
#define MK_ONE_LAUNCH 1
#endif
extern "C" void kernel_launch(void* const* d_in, const int* in_sizes, int n_in, void* d_out, int out_size, void* d_ws, size_t ws_size, hipStream_t stream) {
    static int grid = 0;
    if (grid == 0) {
        if (n_in != 16 || in_sizes[0] != MTOK * DM || out_size != MTOK * DM || ws_size < WS_END) { fprintf(stderr, "kernel_launch: unexpected shapes (n_in %d, ws %zu)\n", n_in, ws_size); grid = -1; return; }
        int dev = 0, cus = 0, per_cu = 0;
        hipGetDevice(&dev); hipDeviceGetAttribute(&cus, hipDeviceAttributeMultiprocessorCount, dev);
        hipFuncSetAttribute((const void*)mega_fwd, hipFuncAttributeMaxDynamicSharedMemorySize, LDS_BYTES);
        if (hipOccupancyMaxActiveBlocksPerMultiprocessor(&per_cu, (const void*)mega_fwd, 512, LDS_BYTES) != hipSuccess || per_cu < 1) per_cu = 1;
        (void)hipGetLastError();
        grid = cus * per_cu;
    }
    if (grid < 0) return;
    Args a{};
    for (int i = 0; i < 16; ++i) a.in[i] = (const float*)d_in[i];
    a.out = (float*)d_out; a.ws = (unsigned char*)d_ws;
    if (hipMemsetAsync((char*)d_ws + WS_CTL, 0, 65536, stream) != hipSuccess) { fprintf(stderr, "memset failed\n"); return; }
#if MK_ONE_LAUNCH
    a.ph_lo = 0; a.ph_hi = NPHASE;
    { void* args[] = {&a}; hipError_t e = hipLaunchCooperativeKernel((const void*)mega_fwd, dim3(grid), dim3(512), args, LDS_BYTES, stream);
      if (e != hipSuccess) fprintf(stderr, "cooperative launch failed: %s (grid %d)\n", hipGetErrorString(e), grid); }
#else
    for (int ph = 0; ph < NPHASE; ++ph) { a.ph_lo = ph; a.ph_hi = ph + 1; void* args[] = {&a};
        hipError_t e = hipLaunchCooperativeKernel((const void*)mega_fwd, dim3(grid), dim3(512), args, LDS_BYTES, stream);
        if (e != hipSuccess) { fprintf(stderr, "launch %d failed: %s\n", ph, hipGetErrorString(e)); break; } }
#endif
}
```
